# Optimizing an MI355X kernel written in HIP

```python
import jax, jax.numpy as jnp
from jax import lax
import numpy as np

D_MODEL = 1024
BATCH = 16
SEQ = 2048
DEPTH = 2
DEC_BATCH = 128
DEC_SEQ = 8
PAST_LEN = 16384
PAGE_SIZE = 128

MIX_W = D_MODEL
ATTN_W = MIX_W // 2
HEAD_DIM = 64
N_HEADS = ATTN_W // HEAD_DIM
N_KV_HEADS = 2
GROUP = N_HEADS // N_KV_HEADS
KV_W = N_KV_HEADS * HEAD_DIM
LRU_W = MIX_W - ATTN_W
N_LRU_BLOCKS = 8
LRU_BLOCK = LRU_W // N_LRU_BLOCKS
CONV_WIDTH = 4
RG_C = 8.0
WINDOW = 128
Q_BLOCK = 128
D_FF = ((8 * D_MODEL // 3 + 127) // 128) * 128
N_MOD = 9
FFN_RES = 0.5
IN_COLS = ATTN_W + 2 * KV_W + 2 * LRU_W
SPLITS = (ATTN_W, ATTN_W + KV_W, ATTN_W + 2 * KV_W, ATTN_W + 2 * KV_W + LRU_W)
RMS_EPS = 1e-6
NEG_INF = -1e30

kernel_name = 'hymba_rglru_swa_sink_alibi_macaron_adaln_step'


def rms_norm(x, eps=RMS_EPS):
    xf = x.astype(jnp.float32)
    return (xf * lax.rsqrt(jnp.mean(xf * xf, axis=-1, keepdims=True) + eps)).astype(x.dtype)


def modulate(x, shift, scale):
    return rms_norm(x) * (1 + scale) + shift


def swiglu(h, w_gate, w_up, w_down):
    return (jax.nn.silu(h @ w_gate) * (h @ w_up)) @ w_down


def alibi_slopes():
    return jnp.asarray([2.0 ** (-8.0 * (hh + 1) / N_HEADS) for hh in range(N_HEADS)], dtype=jnp.float32)


def band_attention(q, k, v, dist, valid, sinks):
    b, nb, tq = q.shape[:3]
    qg = q.reshape(b, nb, tq, N_KV_HEADS, GROUP, HEAD_DIM)
    s = jnp.einsum('bnqkgd,bnskd->bnkgqs', qg, k, preferred_element_type=jnp.float32) * (HEAD_DIM ** -0.5)
    slopes = alibi_slopes().reshape(N_KV_HEADS, GROUP, 1, 1)
    s = s - slopes * dist.astype(jnp.float32)
    s = jnp.where(valid[:, None, None], s, NEG_INF)
    sink = jnp.broadcast_to(sinks.astype(jnp.float32).reshape(N_KV_HEADS, GROUP, 1, 1), s.shape[:-1] + (1,))
    p = jax.nn.softmax(jnp.concatenate([s, sink], axis=-1), axis=-1)[..., :-1]
    o = jnp.einsum('bnkgqs,bnskd->bnqkgd', p.astype(v.dtype), v)
    return o.reshape(b, nb * tq, N_HEADS * HEAD_DIM)


def prompt_window_attention(q, k, v, sinks):
    b, t = q.shape[:2]
    nb = t // Q_BLOCK
    qb = q.reshape(b, nb, Q_BLOCK, N_HEADS, HEAD_DIM)

    def with_prev(z):
        zb = z.reshape(b, nb, Q_BLOCK, N_KV_HEADS, HEAD_DIM)
        prev = jnp.concatenate([jnp.zeros_like(zb[:, :1]), zb[:, :-1]], axis=1)
        return jnp.concatenate([prev, zb], axis=2)

    i = jnp.arange(Q_BLOCK)[:, None]
    j = jnp.arange(2 * Q_BLOCK)[None, :]
    dist = Q_BLOCK + i - j
    band = (dist >= 0) & (dist <= WINDOW)
    no_prev = (jnp.arange(nb)[:, None, None] == 0) & (j[None] < Q_BLOCK)
    valid = band[None] & ~no_prev
    o = band_attention(qb, with_prev(k), with_prev(v), dist, valid, sinks)
    return o, k[:, t - WINDOW:], v[:, t - WINDOW:]


def sample_window_attention(q, k, v, k_buf, v_buf, sinks):
    tq = q.shape[1]
    n_buf = k_buf.shape[1]
    kk = jnp.concatenate([k_buf, k], axis=1)
    vv = jnp.concatenate([v_buf, v], axis=1)
    i = jnp.arange(tq)[:, None]
    j = jnp.arange(n_buf + tq)[None, :]
    dist = n_buf + i - j
    valid = ((dist >= 0) & (dist <= WINDOW))[None]
    o = band_attention(q[:, None], kk[:, None], vv[:, None], dist, valid, sinks)
    return o, kk[:, tq:], vv[:, tq:]


def causal_conv(x, buf, w, b):
    t = x.shape[1]
    xp = jnp.concatenate([buf, x], axis=1)
    y = b + xp[:, 0:t] * w[0]
    for tap in range(1, CONV_WIDTH):
        y = y + xp[:, tap:tap + t] * w[tap]
    return y, xp[:, t:]


def rg_lru(xc, h0, w_r, b_r, w_i, b_i, lam):
    b, t, w = xc.shape
    xb = xc.reshape(b, t, N_LRU_BLOCKS, LRU_BLOCK)
    r = jax.nn.sigmoid(jnp.einsum('btnc,ncd->btnd', xb, w_r).reshape(b, t, w) + b_r)
    gi = jax.nn.sigmoid(jnp.einsum('btnc,ncd->btnd', xb, w_i).reshape(b, t, w) + b_i)
    log_a = -RG_C * r.astype(jnp.float32) * jax.nn.softplus(-lam.astype(jnp.float32))
    a = jnp.exp(log_a)
    u = jnp.sqrt(-jnp.expm1(2.0 * log_a)) * (gi * xc).astype(jnp.float32)

    def step(h, au):
        a_t, u_t = au
        h = a_t * h + u_t
        return h, h

    h_last, hs = lax.scan(step, h0.astype(jnp.float32), (jnp.swapaxes(a, 0, 1), jnp.swapaxes(u, 0, 1)))
    return jnp.swapaxes(hs, 0, 1).astype(xc.dtype), h_last.astype(xc.dtype)


def layer(x, c, conv_buf, h0, k_buf, v_buf,
          w_ada, b_ada, w1_gate, w1_up, w1_down, w_in, q_gain, k_gain, sinks,
          conv_w, conv_b, w_rg, b_rg, w_ig, b_ig, lru_lambda, beta_attn, beta_lru,
          w_out, w2_gate, w2_up, w2_down):
    b, t, _ = x.shape
    mod = (jax.nn.silu(c) @ w_ada + b_ada)[:, None, :]
    sh1, sc1, g1, sh2, sc2, g2, sh3, sc3, g3 = jnp.split(mod, N_MOD, axis=-1)

    x = x + FFN_RES * g1 * swiglu(modulate(x, sh1, sc1), w1_gate, w1_up, w1_down)

    h = modulate(x, sh2, sc2)
    z = h @ w_in
    q, k, v, xr, gr = jnp.split(z, SPLITS, axis=-1)
    q = rms_norm(q.reshape(b, t, N_HEADS, HEAD_DIM)) * q_gain
    k = rms_norm(k.reshape(b, t, N_KV_HEADS, HEAD_DIM)) * k_gain
    v = v.reshape(b, t, N_KV_HEADS, HEAD_DIM)
    if k_buf is None:
        attn, new_k, new_v = prompt_window_attention(q, k, v, sinks)
        conv_buf = jnp.zeros((b, CONV_WIDTH - 1, LRU_W), x.dtype)
        h0 = jnp.zeros((b, LRU_W), x.dtype)
    else:
        attn, new_k, new_v = sample_window_attention(q, k, v, k_buf, v_buf, sinks)
    xc, new_conv = causal_conv(xr, conv_buf, conv_w, conv_b)
    hs, h_last = rg_lru(xc, h0, w_rg, b_rg, w_ig, b_ig, lru_lambda)
    lru = hs * jax.nn.gelu(gr)
    merged = jnp.concatenate([rms_norm(attn) * beta_attn, rms_norm(lru) * beta_lru], axis=-1)
    x = x + g2 * (merged @ w_out)

    x = x + FFN_RES * g3 * swiglu(modulate(x, sh3, sc3), w2_gate, w2_up, w2_down)
    return x, new_k, new_v, new_conv, h_last


def setup_inputs(seed: int = 0) -> dict:
    key = jax.random.key(seed)
    ks = list(jax.random.split(key, 40))

    def nrm(shape, scale):
        return jax.random.normal(ks.pop(), shape, jnp.float32) * scale

    u = jax.random.uniform(ks.pop(), (DEPTH, LRU_W), jnp.float32, minval=0.9, maxval=0.999)
    a_base = u ** (1.0 / RG_C)
    lru_lambda = jnp.log(a_base) - jnp.log1p(-a_base)
    return {
        'x_prompt': nrm((BATCH, SEQ, D_MODEL), 1.0),
        'x_sample': nrm((DEC_BATCH, DEC_SEQ, D_MODEL), 1.0),
        'cache_k': nrm((DEPTH, DEC_BATCH, WINDOW, N_KV_HEADS, HEAD_DIM), 1.0),
        'cache_v': nrm((DEPTH, DEC_BATCH, WINDOW, N_KV_HEADS, HEAD_DIM), 1.0),
        'state_conv': nrm((DEPTH, DEC_BATCH, CONV_WIDTH - 1, LRU_W), 1.0),
        'state_lru': nrm((DEPTH, DEC_BATCH, LRU_W), 0.5),
        'c_prompt': nrm((BATCH, D_MODEL), 1.0),
        'c_sample': nrm((DEC_BATCH, D_MODEL), 1.0),
        'w_ada': nrm((DEPTH, D_MODEL, N_MOD * D_MODEL), 0.02),
        'b_ada': nrm((DEPTH, N_MOD * D_MODEL), 0.02),
        'w1_gate': nrm((DEPTH, D_MODEL, D_FF), D_MODEL ** -0.5),
        'w1_up': nrm((DEPTH, D_MODEL, D_FF), D_MODEL ** -0.5),
        'w1_down': nrm((DEPTH, D_FF, D_MODEL), D_FF ** -0.5),
        'w_in': nrm((DEPTH, D_MODEL, IN_COLS), D_MODEL ** -0.5),
        'q_gain': 1.0 + nrm((DEPTH, HEAD_DIM), 0.05),
        'k_gain': 1.0 + nrm((DEPTH, HEAD_DIM), 0.05),
        'sinks': nrm((DEPTH, N_HEADS), 0.5),
        'conv_w': nrm((DEPTH, CONV_WIDTH, LRU_W), CONV_WIDTH ** -0.5),
        'conv_b': nrm((DEPTH, LRU_W), 0.02),
        'w_rg': nrm((DEPTH, N_LRU_BLOCKS, LRU_BLOCK, LRU_BLOCK), LRU_BLOCK ** -0.5),
        'b_rg': nrm((DEPTH, LRU_W), 0.02),
        'w_ig': nrm((DEPTH, N_LRU_BLOCKS, LRU_BLOCK, LRU_BLOCK), LRU_BLOCK ** -0.5),
        'b_ig': nrm((DEPTH, LRU_W), 0.02),
        'lru_lambda': lru_lambda,
        'beta_attn': 1.0 + nrm((DEPTH, ATTN_W), 0.05),
        'beta_lru': 1.0 + nrm((DEPTH, LRU_W), 0.05),
        'w_out': nrm((DEPTH, MIX_W, D_MODEL), MIX_W ** -0.5),
        'w2_gate': nrm((DEPTH, D_MODEL, D_FF), D_MODEL ** -0.5),
        'w2_up': nrm((DEPTH, D_MODEL, D_FF), D_MODEL ** -0.5),
        'w2_down': nrm((DEPTH, D_FF, D_MODEL), D_FF ** -0.5),
    }


def reference(x_prompt, x_sample, cache_k, cache_v, state_conv, state_lru, c_prompt, c_sample,
              w_ada, b_ada, w1_gate, w1_up, w1_down, w_in, q_gain, k_gain, sinks,
              conv_w, conv_b, w_rg, b_rg, w_ig, b_ig, lru_lambda, beta_attn, beta_lru,
              w_out, w2_gate, w2_up, w2_down):
    yp = x_prompt
    ys = x_sample
    kp_l, vp_l, cp_l, hp_l = [], [], [], []
    ks_l, vs_l, cs_l, hs_l = [], [], [], []
    for l in range(DEPTH):
        lw = (w_ada[l], b_ada[l], w1_gate[l], w1_up[l], w1_down[l], w_in[l], q_gain[l], k_gain[l],
              sinks[l], conv_w[l], conv_b[l], w_rg[l], b_rg[l], w_ig[l], b_ig[l], lru_lambda[l],
              beta_attn[l], beta_lru[l], w_out[l], w2_gate[l], w2_up[l], w2_down[l])
        yp, kp, vp, cp, hp = layer(yp, c_prompt, None, None, None, None, *lw)
        ys, kS, vS, cS, hS = layer(ys, c_sample, state_conv[l], state_lru[l], cache_k[l], cache_v[l], *lw)
        kp_l.append(kp); vp_l.append(vp); cp_l.append(cp); hp_l.append(hp)
        ks_l.append(kS); vs_l.append(vS); cs_l.append(cS); hs_l.append(hS)
    return (yp, ys,
            jnp.stack(kp_l), jnp.stack(vp_l), jnp.stack(cp_l), jnp.stack(hp_l),
            jnp.stack(ks_l), jnp.stack(vs_l), jnp.stack(cs_l), jnp.stack(hs_l))
```

```cpp
#include <hip/hip_runtime.h>
#include <hip/hip_cooperative_groups.h>
#include <cstdio>
#include <cstdint>
namespace cg = cooperative_groups;
namespace pg8 {
#define PG8_LAS __attribute__((address_space(3)))
typedef unsigned short bf16_t;
typedef short bf16x8 __attribute__((ext_vector_type(8)));
typedef float f32x4 __attribute__((ext_vector_type(4)));
typedef unsigned u32x4 __attribute__((ext_vector_type(4)));
typedef unsigned u32x2 __attribute__((ext_vector_type(2)));
constexpr int BM = 256, BK = 64, HALF = 128, HTB = HALF * BK * 2  , STAGE_BYTES = 8 * HTB, NXCD = 8, WGM = 8;

__host__ __device__ __forceinline__ int lds_byte(int r, int c) { const int st = (r >> 4) * 2 + (c >> 5), rr = r & 15, cc = c & 31, ob = rr * 64 + cc * 2; return st * 1024 + (ob ^ (((ob >> 9) & 1) << 5)); }
__host__ __device__ __forceinline__ void stage_rc(int b, int& R, int& C) { const int st = b / 1024, sb = b % 1024, swz = sb ^ (((sb >> 9) & 1) << 5); R = (st >> 1) * 16 + swz / 64; C = (st & 1) * 32 + (swz % 64) / 2; }
__host__ __device__ __forceinline__ int perm32(int rho) { const int n = rho >> 4, i = rho & 15; return 8 * (i >> 2) + 4 * n + (i & 3); }

struct Unit { int pm, pn, k0, nt; };
struct Gemm { const bf16_t* A; const bf16_t* Bt; int M, N, K; };

struct StaticOrder {
    int nM, nN, nwg, G, c;
    __host__ __device__ void init(int M, int N, int G_, int c_) { nM = M / BM; nN = N / BM; nwg = nM * nN; G = G_; c = c_; }
    __host__ __device__ bool next(int i, Unit& u) const {
        const long L = (long)i * G + c; if (L >= nwg) return false;
        int wgid = (int)L; { const int q = nwg / NXCD, r = nwg % NXCD, xcd = wgid % NXCD, off = wgid / NXCD; wgid = (xcd < r ? xcd * (q + 1) : r * (q + 1) + (xcd - r) * q) + off; }
        const int nig = WGM * nN, gid = wgid / nig, fm = gid * WGM, gsz = (nM - fm) < WGM ? (nM - fm) : WGM;
        u.pm = fm + ((wgid % nig) % gsz); u.pn = (wgid % nig) / gsz; u.k0 = 0; u.nt = 0; return true;
    }
    __device__ __forceinline__ void a_ready(const Unit&) const {}
    __device__ __forceinline__ void done(const Unit&) const {}
};
struct SplitOrder {
    StaticOrder so; int nfull, nch, nN, G, c;
    __host__ __device__ void init(int N, int K, int G_, int c_) { so.init(128 * BM, N, G_, c_); nN = N / BM; nfull = 128 * nN; nch = K / 256; G = G_; c = c_; }
    __host__ __device__ bool next(int i, Unit& u) const {
        const long L = (long)i * G + c;
        if (L < nfull) { const int nr = nfull / G; return so.next((nr * G == nfull && i < nr) ? nr - 1 - i : i, u); }
        const int j = (int)(L - nfull); if (j >= 4 * nN * nch) return false;
        const int ch = j / (4 * nN), rem = j % (4 * nN);
        u.pm = 128 + rem / nN; u.pn = rem % nN; u.k0 = 4 * ch; u.nt = 4; return true;
    }
    __device__ __forceinline__ void a_ready(const Unit&) const {}
    __device__ __forceinline__ void done(const Unit&) const {}
};


__device__ __forceinline__ unsigned cvt_pk_bf16(float lo, float hi) { unsigned r; asm volatile("v_cvt_pk_bf16_f32 %0, %1, %2" : "=v"(r) : "v"(lo), "v"(hi)); return r; }
typedef float f32x2 __attribute__((ext_vector_type(2)));
constexpr int MP_ROWS = 32768;
struct EpiSwiglu {
    static constexpr bool PERM = true, AFTER_DRAIN = false;
    bf16_t* O; int ldc;
    __device__ __forceinline__ void operator()(const f32x4 (&acc)[2][2][4][2], const Unit& u, int wr, int wc, int fr, int fq) const {
        const int row0 = u.pm * BM + wr * 64 + fr, col0 = u.pn * 128 + wc * 32 + 8 * fq;
#pragma unroll
        for (int ai = 0; ai < 2; ++ai)
#pragma unroll
            for (int m = 0; m < 4; ++m) {
                bf16_t* p = O + (size_t)(row0 + ai * HALF + m * 16) * ldc + col0;
                float v[8];
#pragma unroll
                for (int n = 0; n < 2; ++n)
#pragma unroll
                    for (int e = 0; e < 4; ++e) { const float g = acc[ai][0][m][n][e], up = acc[ai][1][m][n][e];
                        v[n * 4 + e] = g * up * __builtin_amdgcn_rcpf(1.f + __expf(-g)); }
                u32x4 w; w.x = cvt_pk_bf16(v[0], v[1]); w.y = cvt_pk_bf16(v[2], v[3]); w.z = cvt_pk_bf16(v[4], v[5]); w.w = cvt_pk_bf16(v[6], v[7]);
                *(u32x4*)p = w;
            }
    }
};
struct EpiPlainBf16 {
    static constexpr bool PERM = true, AFTER_DRAIN = false;
    bf16_t* O; int ldc;
    __device__ __forceinline__ void operator()(const f32x4 (&acc)[2][2][4][2], const Unit& u, int wr, int wc, int fr, int fq) const {
        const int row0 = u.pm * BM + wr * 64 + fr, col0 = u.pn * BM + wc * 32 + 8 * fq;
#pragma unroll
        for (int ai = 0; ai < 2; ++ai)
#pragma unroll
            for (int m = 0; m < 4; ++m) {
                bf16_t* p = O + (size_t)(row0 + ai * HALF + m * 16) * ldc + col0;
#pragma unroll
                for (int bj = 0; bj < 2; ++bj) { const f32x4 v0 = acc[ai][bj][m][0], v1 = acc[ai][bj][m][1];
                    u32x4 w; w.x = cvt_pk_bf16(v0[0], v0[1]); w.y = cvt_pk_bf16(v0[2], v0[3]); w.z = cvt_pk_bf16(v1[0], v1[1]); w.w = cvt_pk_bf16(v1[2], v1[3]);
                    *(u32x4*)(p + bj * HALF) = w; }
            }
    }
};
template <int MODE> struct EpiResid {
    static constexpr bool PERM = false, AFTER_DRAIN = false;
    const float* resF; const bf16_t* resB; float* outF; bf16_t* outB; const float* gate; float coef; float* part;
    __device__ __forceinline__ void operator()(const f32x4 (&acc)[2][2][4][2], const Unit& u, int wr, int wc, int fr, int fq) const {
        const int row0 = u.pm * BM + wr * 64 + fr, col0 = u.pn * BM + wc * 32 + 4 * fq;
        if (u.nt != 0) {
            float* pb = part + (size_t)(u.k0 >> 2) * 1024 * 1024;
#pragma unroll
            for (int aim = 0; aim < 4; ++aim) { const int ai = aim >> 1, m0 = (aim & 1) * 2;
                f32x4 g[4][2][2];
#pragma unroll
                for (int m = m0; m < m0 + 2; ++m) { const int row = row0 + ai * HALF + m * 16 - MP_ROWS; const float* gp = gate + (size_t)(16 + (row >> 3)) * 9216 + col0;
#pragma unroll
                    for (int bj = 0; bj < 2; ++bj)
#pragma unroll
                        for (int n = 0; n < 2; ++n) g[m][bj][n] = *(const f32x4*)(gp + bj * HALF + n * 16); }
                asm volatile("" ::: "memory");
#pragma unroll
                for (int m = m0; m < m0 + 2; ++m) { const int row = row0 + ai * HALF + m * 16 - MP_ROWS; float* op = pb + (size_t)row * 1024 + col0;
#pragma unroll
                    for (int bj = 0; bj < 2; ++bj)
#pragma unroll
                        for (int n = 0; n < 2; ++n) *(f32x4*)(op + bj * HALF + n * 16) = (g[m][bj][n] * coef) * acc[ai][bj][m][n]; }
                asm volatile("" ::: "memory");
            }
            return;
        }
        const float* gp = gate + (size_t)(u.pm >> 3) * 9216 + col0;
        f32x4 gc[2][2];
#pragma unroll
        for (int bj = 0; bj < 2; ++bj)
#pragma unroll
            for (int n = 0; n < 2; ++n) gc[bj][n] = *(const f32x4*)(gp + bj * HALF + n * 16);
        asm volatile("" ::: "memory");
#pragma unroll
        for (int bj = 0; bj < 2; ++bj)
#pragma unroll
            for (int n = 0; n < 2; ++n) gc[bj][n] = gc[bj][n] * coef;
#pragma unroll
        for (int aim = 0; aim < 4; ++aim) { const int ai = aim >> 1, m0 = (aim & 1) * 2;
            f32x4 r[4][2][2]; u32x2 rb[4][2][2];
#pragma unroll
            for (int m = m0; m < m0 + 2; ++m) { const size_t off = (size_t)(row0 + ai * HALF + m * 16) * 1024 + col0;
#pragma unroll
                for (int bj = 0; bj < 2; ++bj)
#pragma unroll
                    for (int n = 0; n < 2; ++n) { if (MODE == 0) r[m][bj][n] = *(const f32x4*)(resF + off + bj * HALF + n * 16); else rb[m][bj][n] = *(const u32x2*)(resB + off + bj * HALF + n * 16); } }
            asm volatile("" ::: "memory");
#pragma unroll
            for (int m = m0; m < m0 + 2; ++m) { const size_t off = (size_t)(row0 + ai * HALF + m * 16) * 1024 + col0;
#pragma unroll
                for (int bj = 0; bj < 2; ++bj)
#pragma unroll
                    for (int n = 0; n < 2; ++n) {
                        f32x4 x;
                        if (MODE == 0) x = r[m][bj][n];
                        else { const u32x2 w = rb[m][bj][n]; x = (f32x4){__uint_as_float(w.x << 16), __uint_as_float(w.x & 0xffff0000u), __uint_as_float(w.y << 16), __uint_as_float(w.y & 0xffff0000u)}; }
                        const f32x4 o = x + gc[bj][n] * acc[ai][bj][m][n];
                        if (MODE == 2) *(f32x4*)(outF + off + bj * HALF + n * 16) = o;
                        else { u32x2 w; w.x = cvt_pk_bf16(o[0], o[1]); w.y = cvt_pk_bf16(o[2], o[3]); *(u32x2*)(outB + off + bj * HALF + n * 16) = w; } } }
            asm volatile("" ::: "memory");
        }
    }
};
struct EpiMod {
    static constexpr bool PERM = false, AFTER_DRAIN = false;
    float* mod; const float* bada;
    __device__ __forceinline__ void operator()(const f32x4 (&acc)[2][2][4][2], const Unit& u, int wr, int wc, int fr, int fq) const {
        const int row0 = wr * 64 + fr, n0 = u.pn * BM + wc * 32 + 4 * fq, l = n0 / 9216, j0 = n0 - l * 9216;
        f32x4 bv[2][2];
#pragma unroll
        for (int bj = 0; bj < 2; ++bj)
#pragma unroll
            for (int n = 0; n < 2; ++n) bv[bj][n] = *(const f32x4*)(bada + (size_t)l * 9216 + j0 + bj * HALF + n * 16);
        asm volatile("" ::: "memory");
#pragma unroll
        for (int ai = 0; ai < 2; ++ai)
#pragma unroll
            for (int m = 0; m < 4; ++m) {
                const int row = row0 + ai * HALF + m * 16;
                if (row < 144) {
                    float* op = mod + ((size_t)l * 144 + row) * 9216 + j0;
#pragma unroll
                    for (int bj = 0; bj < 2; ++bj)
#pragma unroll
                        for (int n = 0; n < 2; ++n) { const int c = bj * HALF + n * 16; *(f32x4*)(op + c) = acc[ai][bj][m][n] + bv[bj][n]; }
                }
            }
    }
};
template <class Epi, class Sched, bool ALIGN_EPI = false, bool SP2 = false>
__device__ __forceinline__ void gemm_phase(PG8_LAS unsigned char* lds, const Gemm g, const Sched& S, const Epi& E) {
    int tid_ = threadIdx.x; asm volatile("" : "+v"(tid_));
    const int tid = tid_, wid = __builtin_amdgcn_readfirstlane(tid >> 6), lane = tid & 63, wr = wid >> 2, wc = wid & 3, fr = lane & 15, fq = lane >> 4;
    const int K = g.K, ntf = K / BK;
    unsigned voffA[2], voffB[2];
#pragma unroll
    for (int i = 0; i < 2; ++i) { int R, C; stage_rc(tid * 16 + i * 8192, R, C); const int Rb = Epi::PERM ? ((R & ~31) + perm32(R & 31)) : R;
        voffA[i] = (unsigned)(R * K + C) * 2u; voffB[i] = (unsigned)(Rb * K + C) * 2u; }
    const size_t kstep = (size_t)(BK * 2);
    const size_t hstep = (size_t)HALF * K * 2;
    const size_t tstep = 2 * hstep;
    const unsigned ldsw = (unsigned)wid * 1024u;
    const int aoff = lds_byte(wr * 64 + fr, fq * 8), boff = lds_byte(wc * 32 + fr, fq * 8);
#define PG8_SA(b, h) (((b) * 2 + (h)) * HTB)
#define PG8_SB(b, h) ((4 + (b) * 2 + (h)) * HTB)
#define PG8_STAGE(bufoff, gbase, voff) do { _Pragma("unroll") for (int _i = 0; _i < 2; ++_i) \
        __builtin_amdgcn_global_load_lds((const unsigned*)((const char*)(gbase) + (voff)[_i]), (PG8_LAS unsigned*)(lds + (bufoff) + ldsw + _i * 8192), 16, 0, 0); } while (0)
#define PG8_LDA(dst, b, h) do { _Pragma("unroll") for (int m = 0; m < 4; ++m) _Pragma("unroll") for (int k = 0; k < 2; ++k) dst[m][k] = *(const PG8_LAS bf16x8*)(lds + PG8_SA(b, h) + aoff + m * 2048 + k * 1024); } while (0)
#define PG8_LDB(dst, b, h) do { _Pragma("unroll") for (int n = 0; n < 2; ++n) _Pragma("unroll") for (int k = 0; k < 2; ++k) dst[n][k] = *(const PG8_LAS bf16x8*)(lds + PG8_SB(b, h) + boff + n * 2048 + k * 1024); } while (0)
#define PG8_MMA(ai, bj, At, Bt) do { __builtin_amdgcn_s_setprio(1); _Pragma("unroll") for (int m = 0; m < 4; ++m) _Pragma("unroll") for (int n = 0; n < 2; ++n) _Pragma("unroll") for (int k = 0; k < 2; ++k) \
        acc[ai][bj][m][n] = __builtin_amdgcn_mfma_f32_16x16x32_bf16(Bt[n][k], At[m][k], acc[ai][bj][m][n], 0, 0, 0); __builtin_amdgcn_s_setprio(0); } while (0)
#define PG8_WAIT_V(n) asm volatile("s_waitcnt vmcnt(" #n ")" ::: "memory")
#define PG8_WAIT_L(n) asm volatile("s_waitcnt lgkmcnt(" #n ")" ::: "memory")
#define PG8_BAR __builtin_amdgcn_s_barrier()
#define PG8_SCHED __builtin_amdgcn_sched_barrier(0)
    Unit cur, nxt; int ui = 0;
    if (!S.next(0, cur)) return;
    f32x4 acc[2][2][4][2];
#pragma unroll
    for (int a = 0; a < 2; ++a)
#pragma unroll
        for (int b = 0; b < 2; ++b)
#pragma unroll
            for (int m = 0; m < 4; ++m)
#pragma unroll
                for (int n = 0; n < 2; ++n) acc[a][b][m][n] = (f32x4){0.f, 0.f, 0.f, 0.f};
    bf16x8 At[4][2], B0[2][2], B1[2][2];
    int nt = cur.nt ? cur.nt : ntf;
    const char* cA = (const char*)g.A + (size_t)cur.pm * tstep + (size_t)cur.k0 * kstep; const char* cB = (const char*)g.Bt + (size_t)cur.pn * tstep + (size_t)cur.k0 * kstep;
    S.a_ready(cur);
    if constexpr (SP2) {
        PG8_STAGE(PG8_SB(0, 0), cB, voffB); PG8_STAGE(PG8_SB(0, 1), cB + hstep, voffB); PG8_STAGE(PG8_SA(0, 0), cA, voffA); PG8_STAGE(PG8_SA(0, 1), cA + hstep, voffA);
        if (wr == 1) PG8_BAR;
        PG8_WAIT_V(2); PG8_BAR;
        PG8_STAGE(PG8_SB(1, 0), cB + kstep, voffB); PG8_STAGE(PG8_SA(1, 0), cA + kstep, voffA); PG8_STAGE(PG8_SB(1, 1), cB + hstep + kstep, voffB);
        PG8_WAIT_V(6); PG8_BAR;
    } else {
        PG8_STAGE(PG8_SB(0, 0), cB, voffB); PG8_STAGE(PG8_SA(0, 0), cA, voffA); PG8_STAGE(PG8_SB(0, 1), cB + hstep, voffB); PG8_STAGE(PG8_SA(0, 1), cA + hstep, voffA);
        if (wr == 1) PG8_BAR;
        PG8_WAIT_V(4); PG8_BAR;
        PG8_STAGE(PG8_SB(1, 0), cB + kstep, voffB); PG8_STAGE(PG8_SA(1, 0), cA + kstep, voffA); PG8_STAGE(PG8_SB(1, 1), cB + hstep + kstep, voffB);
        PG8_WAIT_V(6); PG8_BAR;
    }
    for (;;) {
        const bool has_next = S.next(ui + 1, nxt);
        const char* nA = has_next ? (const char*)g.A + (size_t)nxt.pm * tstep + (size_t)nxt.k0 * kstep : cA; const char* nB = has_next ? (const char*)g.Bt + (size_t)nxt.pn * tstep + (size_t)nxt.k0 * kstep : cB;
        for (int t = 0; t < nt; t += 2) {
            const bool last = (t == nt - 2);
            const char* a1 = cA + (size_t)(t + 1) * kstep;
            const char* a2 = last ? nA : cA + (size_t)(t + 2) * kstep; const char* b2 = last ? nB : cB + (size_t)(t + 2) * kstep;
            const char* a3 = a2 + kstep; const char* b3 = b2 + kstep;
            if (last && has_next) S.a_ready(nxt);
            if constexpr (SP2) {
            PG8_LDB(B0, 0, 0); PG8_LDB(B1, 0, 1); PG8_SCHED; PG8_LDA(At, 0, 0); PG8_STAGE(PG8_SA(1, 1), a1 + hstep, voffA);
            PG8_WAIT_V(8); PG8_WAIT_L(0); PG8_BAR; PG8_MMA(0, 0, At, B0); PG8_MMA(0, 1, At, B1); PG8_BAR; PG8_SCHED;
            PG8_LDA(At, 0, 1); PG8_STAGE(PG8_SB(0, 0), b2, voffB); PG8_STAGE(PG8_SB(0, 1), b2 + hstep, voffB); PG8_STAGE(PG8_SA(0, 0), a2, voffA);
            PG8_WAIT_V(8); PG8_WAIT_L(0); PG8_BAR; PG8_MMA(1, 0, At, B0); PG8_MMA(1, 1, At, B1); PG8_BAR; PG8_SCHED;
            PG8_LDB(B0, 1, 0); PG8_LDB(B1, 1, 1); PG8_SCHED; PG8_LDA(At, 1, 0); PG8_STAGE(PG8_SA(0, 1), a2 + hstep, voffA);
            PG8_WAIT_V(8); PG8_WAIT_L(0); PG8_BAR; PG8_MMA(0, 0, At, B0); PG8_MMA(0, 1, At, B1); PG8_BAR; PG8_SCHED;
            PG8_LDA(At, 1, 1); PG8_STAGE(PG8_SB(1, 0), b3, voffB); PG8_STAGE(PG8_SB(1, 1), b3 + hstep, voffB); PG8_STAGE(PG8_SA(1, 0), a3, voffA);
            PG8_WAIT_V(8); PG8_WAIT_L(0); PG8_BAR; PG8_MMA(1, 0, At, B0); PG8_MMA(1, 1, At, B1); PG8_BAR; PG8_SCHED;
            } else {
            PG8_LDB(B0, 0, 0); PG8_SCHED; PG8_LDA(At, 0, 0); PG8_STAGE(PG8_SA(1, 1), a1 + hstep, voffA);
            PG8_WAIT_L(8); PG8_BAR; PG8_WAIT_L(0); PG8_MMA(0, 0, At, B0); PG8_BAR; PG8_SCHED;
            PG8_LDB(B1, 0, 1); PG8_STAGE(PG8_SB(0, 0), b2, voffB);
            PG8_BAR; PG8_WAIT_L(0); PG8_MMA(0, 1, At, B1); PG8_BAR;
            PG8_LDA(At, 0, 1); PG8_STAGE(PG8_SA(0, 0), a2, voffA);
            PG8_BAR; PG8_WAIT_L(0); PG8_MMA(1, 0, At, B0); PG8_BAR; PG8_SCHED;
            PG8_STAGE(PG8_SB(0, 1), b2 + hstep, voffB);
            PG8_WAIT_V(6); PG8_BAR; PG8_MMA(1, 1, At, B1); PG8_BAR;
            PG8_LDB(B0, 1, 0); PG8_SCHED; PG8_LDA(At, 1, 0); PG8_STAGE(PG8_SA(0, 1), a2 + hstep, voffA);
            PG8_WAIT_L(8); PG8_BAR; PG8_WAIT_L(0); PG8_MMA(0, 0, At, B0); PG8_BAR; PG8_SCHED;
            PG8_LDB(B1, 1, 1); PG8_STAGE(PG8_SB(1, 0), b3, voffB);
            PG8_BAR; PG8_WAIT_L(0); PG8_MMA(0, 1, At, B1); PG8_BAR;
            PG8_LDA(At, 1, 1); PG8_STAGE(PG8_SA(1, 0), a3, voffA);
            PG8_BAR; PG8_WAIT_L(0); PG8_MMA(1, 0, At, B0); PG8_BAR; PG8_SCHED;
            PG8_STAGE(PG8_SB(1, 1), b3 + hstep, voffB);
            PG8_WAIT_V(6); PG8_BAR; PG8_MMA(1, 1, At, B1); PG8_BAR;
            }
        }
        if constexpr (ALIGN_EPI) { if (wr == 0) PG8_BAR; }
        if constexpr (!Epi::AFTER_DRAIN) { E(acc, cur, wr, wc, fr, fq); S.done(cur); }
        if (!has_next) break;
#pragma unroll
        for (int a = 0; a < 2; ++a)
#pragma unroll
            for (int b = 0; b < 2; ++b)
#pragma unroll
                for (int m = 0; m < 4; ++m)
#pragma unroll
                    for (int n = 0; n < 2; ++n) acc[a][b][m][n] = (f32x4){0.f, 0.f, 0.f, 0.f};
        cur = nxt; cA = nA; cB = nB; ++ui; nt = cur.nt ? cur.nt : ntf;
        if constexpr (ALIGN_EPI) { if (wr == 1) PG8_BAR; }
    }
    PG8_WAIT_V(0);
    if constexpr (!ALIGN_EPI) { if (wr == 0) PG8_BAR; }
    PG8_BAR;
    if constexpr (Epi::AFTER_DRAIN) { E.fused(acc, cur, wr, wc, fr, fq, lds, wid, lane); S.done(cur); }
#undef PG8_SA
#undef PG8_SB
#undef PG8_STAGE
#undef PG8_LDA
#undef PG8_LDB
#undef PG8_MMA
#undef PG8_WAIT_V
#undef PG8_WAIT_L
#undef PG8_BAR
#undef PG8_SCHED
}
}
typedef unsigned short bfu;
typedef short s16x8 __attribute__((ext_vector_type(8)));
typedef float f4 __attribute__((ext_vector_type(4)));
typedef float f16v __attribute__((ext_vector_type(16)));
typedef unsigned u4 __attribute__((ext_vector_type(4)));
typedef unsigned u2 __attribute__((ext_vector_type(2)));
#define LAS3 __attribute__((address_space(3)))

constexpr int DM = 1024, MP = 32768, MS = 1024, MT = MP + MS, DFF = 2816, INC = 1792, NMODC = 9216, NCB = 144;
constexpr size_t MiB = 1u << 20;
constexpr size_t WS_CTL = 0, WS_MOD = 1 * MiB, WS_W = 12 * MiB, WS_H = 90 * MiB, WS_MG = 156 * MiB, WS_ACT = 222 * MiB, WS_END = 404 * MiB;
constexpr size_t W_UP1 = 0, W_DN1 = W_UP1 + (size_t)5632 * 1024, W_IN = W_DN1 + (size_t)1024 * 2816, W_OUT = W_IN + (size_t)1792 * 1024,
                 W_UP2 = W_OUT + (size_t)1024 * 1024, W_DN2 = W_UP2 + (size_t)5632 * 1024, W_LAYER = W_DN2 + (size_t)1024 * 2816;
static_assert(WS_W + 2 * W_LAYER * 2 <= WS_H, "weights fit");
constexpr size_t O_YP = 0, O_YS = 33554432, O_KP = 34603008, O_VP = O_KP + 524288, O_CP = O_VP + 524288, O_LP = O_CP + 49152, O_KS = O_LP + 16384,
                 O_VS = O_KS + 4194304, O_CS = O_VS + 4194304, O_LS = O_CS + 393216;
constexpr int LDS_BYTES = 131072 + 256;

typedef float f32x2_t __attribute__((ext_vector_type(2))); typedef __bf16 bf16x2_t __attribute__((ext_vector_type(2)));
__device__ __forceinline__ unsigned pkbf(float lo, float hi) { f32x2_t v = {lo, hi}; bf16x2_t b = __builtin_convertvector(v, bf16x2_t); return __builtin_bit_cast(unsigned, b); }
__device__ __forceinline__ float bflo(unsigned w) { return __uint_as_float(w << 16); }
__device__ __forceinline__ float bfhi(unsigned w) { return __uint_as_float(w & 0xffff0000u); }
__device__ __forceinline__ float bf1(bfu b) { return __uint_as_float(((unsigned)b) << 16); }
__device__ __forceinline__ bfu tobf(float f) { return (bfu)(pkbf(f, 0.f) & 0xffffu); }
__device__ __forceinline__ float sigm(float x) { return __builtin_amdgcn_rcpf(1.f + __expf(-x)); }
__device__ __forceinline__ float gelu_tanh(float x) { const float t = 0.7978845608028654f * (x + 0.044715f * x * x * x); return x * sigm(2.f * t); }
__device__ __forceinline__ int crow(int r, int hi) { return (r & 3) + 8 * (r >> 2) + 4 * hi; }

struct Params { const float* in[30]; float* out; unsigned char* ws; };

__device__ __forceinline__ int wq_next(unsigned* ctr, volatile int* slot) {
    __syncthreads();
    if (threadIdx.x == 0) *slot = (int)atomicAdd(ctr, 1u);
    __syncthreads();
    return *slot;
}

__device__ __forceinline__ void transpose_item(const float* W, int K, int N, bfu* WT, int mode, float* scr, int item, int lane) {
    const int nblk = N / 32, kb = item / nblk, nb = item % nblk, k0 = 64 * kb, n0 = 32 * nb;
    const int r0 = mode == 0 ? n0 : ((n0 >> 7) * 256 + (n0 & 127) + (mode == 2 ? 128 : 0));
    float wv[32];
#pragma unroll
    for (int i = 0; i < 32; ++i) { const int kk = 2 * i + (lane >> 5); wv[i] = __builtin_nontemporal_load(W + (size_t)(k0 + kk) * N + n0 + (lane & 31)); }
#pragma unroll
    for (int i = 0; i < 32; ++i) { const int kk = 2 * i + (lane >> 5); scr[kk * 33 + (lane & 31)] = wv[i]; }
    asm volatile("s_waitcnt lgkmcnt(0)" ::: "memory");
    const int c = lane & 7;
#pragma unroll
    for (int jj = 0; jj < 4; ++jj) { const int n = (lane >> 3) + 8 * jj; const float* s = scr + (8 * c) * 33 + n;
        u4 o; o.x = pkbf(s[0], s[33]); o.y = pkbf(s[66], s[99]); o.z = pkbf(s[132], s[165]); o.w = pkbf(s[198], s[231]);
        *(u4*)(WT + (size_t)(r0 + n) * K + k0 + 8 * c) = o; }
    asm volatile("s_waitcnt lgkmcnt(0)" ::: "memory");
}
constexpr int TI_BIG = 1408, TI_IN = 896, TI_OUT = 512, TI_ADA = 4608, TI_LAYER = 6 * TI_BIG + TI_IN + TI_OUT + TI_ADA;
constexpr int N_SC_ITEMS = 8, N_TR_WG_ITEMS = 2 * TI_LAYER / 8;
constexpr size_t WS_WADA = 404 * MiB, WS_SC = 440 * MiB;
__device__ __forceinline__ void prologue_phase(const Params& p, unsigned char* lds, unsigned* ctr, volatile int* slot) {
    int tid_ = threadIdx.x; asm volatile("" : "+v"(tid_));
    const int tid = tid_, lane = tid & 63, w = tid >> 6;
    bfu* wsW = (bfu*)(p.ws + WS_W); bfu* wada = (bfu*)(p.ws + WS_WADA); bfu* SC = (bfu*)(p.ws + WS_SC);
    for (;;) {
        const int it = wq_next(ctr, slot);
        if (it >= N_SC_ITEMS + N_TR_WG_ITEMS) break;
        if (it < N_SC_ITEMS) {
            const int row = it * 32 + (tid >> 4), c0 = (tid & 15) * 64;
            const float* src = row < 16 ? p.in[6] + (size_t)row * 1024 : (row < 144 ? p.in[7] + (size_t)(row - 16) * 1024 : nullptr);
#pragma unroll
            for (int e = 0; e < 16; ++e) { f4 c = src ? *(const f4*)(src + c0 + 4 * e) : (f4){0.f, 0.f, 0.f, 0.f};
                u2 o; o.x = pkbf(c.x * sigm(c.x), c.y * sigm(c.y)); o.y = pkbf(c.z * sigm(c.z), c.w * sigm(c.w));
                *(u2*)(SC + (size_t)row * 1024 + c0 + 4 * e) = o; }
            continue; }
        int wi = (it - N_SC_ITEMS) * 8 + w; const int l = wi / TI_LAYER; int r = wi % TI_LAYER;
        bfu* wl = wsW + (size_t)l * W_LAYER; float* scr = (float*)lds + w * (64 * 33);
        if (r < TI_ADA) { transpose_item(p.in[8] + (size_t)l * 1024 * NMODC, 1024, NMODC, wada + (size_t)l * NMODC * 1024, 0, scr, r, lane); continue; } r -= TI_ADA;
        if (r < TI_BIG) { transpose_item(p.in[10] + (size_t)l * 1024 * DFF, 1024, DFF, wl + W_UP1, 1, scr, r, lane); continue; } r -= TI_BIG;
        if (r < TI_BIG) { transpose_item(p.in[11] + (size_t)l * 1024 * DFF, 1024, DFF, wl + W_UP1, 2, scr, r, lane); continue; } r -= TI_BIG;
        if (r < TI_BIG) { transpose_item(p.in[12] + (size_t)l * DFF * 1024, DFF, 1024, wl + W_DN1, 0, scr, r, lane); continue; } r -= TI_BIG;
        if (r < TI_IN) { transpose_item(p.in[13] + (size_t)l * 1024 * INC, 1024, INC, wl + W_IN, 0, scr, r, lane); continue; } r -= TI_IN;
        if (r < TI_OUT) { transpose_item(p.in[26] + (size_t)l * 1024 * 1024, 1024, 1024, wl + W_OUT, 0, scr, r, lane); continue; } r -= TI_OUT;
        if (r < TI_BIG) { transpose_item(p.in[27] + (size_t)l * 1024 * DFF, 1024, DFF, wl + W_UP2, 1, scr, r, lane); continue; } r -= TI_BIG;
        if (r < TI_BIG) { transpose_item(p.in[28] + (size_t)l * 1024 * DFF, 1024, DFF, wl + W_UP2, 2, scr, r, lane); continue; } r -= TI_BIG;
        transpose_item(p.in[29] + (size_t)l * DFF * 1024, DFF, 1024, wl + W_DN2, 0, scr, r, lane);
    }
}

__device__ __forceinline__ float wave_sum(float v) {
#pragma unroll
    for (int o = 1; o < 64; o <<= 1) v += __shfl_xor(v, o);
    return v;
}
__device__ __forceinline__ void norm_phase(const float* xP, const float* xS, const float* modl, int shi, int sci, bfu* H, const float* part, int nch, float* XSout, const bfu* XbP) {
    int tid_ = threadIdx.x; asm volatile("" : "+v"(tid_));
    const int lane = tid_ & 63, gw = blockIdx.x * 8 + (tid_ >> 6), NGW = gridDim.x * 8;
    f4 v[4], sh[4], sc[4];
    auto ld = [&](int row, f4 (&vv)[4], f4 (&shh)[4], f4 (&scc)[4]) {
        const bool pr = row < MP;
        const f4* xr = (const f4*)(pr ? xP + (size_t)row * DM : xS + (size_t)(row - MP) * DM) + lane;
        const int cb = pr ? (row >> 11) : 16 + ((row - MP) >> 3);
        const f4* shp = (const f4*)(modl + (size_t)cb * NMODC + shi * DM) + lane; const f4* scp = (const f4*)(modl + (size_t)cb * NMODC + sci * DM) + lane;
#pragma unroll
        for (int j = 0; j < 4; ++j) { shh[j] = shp[64 * j]; scc[j] = scp[64 * j]; }
        if (XbP != nullptr && pr) {
            const u2* hr = (const u2*)(XbP + (size_t)row * DM) + lane;
#pragma unroll
            for (int j = 0; j < 4; ++j) { const u2 w = __builtin_nontemporal_load(hr + 64 * j); vv[j] = (f4){bflo(w.x), bfhi(w.x), bflo(w.y), bfhi(w.y)}; }
        } else {
#pragma unroll
            for (int j = 0; j < 4; ++j) vv[j] = __builtin_nontemporal_load(xr + 64 * j);
        }
    };
    if (gw < MT) ld(gw, v, sh, sc);
    for (int row = gw; row < MT; row += NGW) {
        f4 vn[4], shn[4], scn[4];
        const int nrow = row + NGW;
        if (nrow < MT) ld(nrow, vn, shn, scn);
        if (nch > 0 && row >= MP) {
            const f4* pp = (const f4*)(part + (size_t)(row - MP) * DM) + lane;
            for (int ch = 0; ch < nch; ch += 4) {
                f4 t[4][4];
#pragma unroll
                for (int c2 = 0; c2 < 4; ++c2)
#pragma unroll
                    for (int j = 0; j < 4; ++j) t[c2][j] = (ch + c2 < nch) ? pp[(size_t)(ch + c2) * (1024 * 1024 / 4) + 64 * j] : (f4){0.f, 0.f, 0.f, 0.f};
#pragma unroll
                for (int c2 = 0; c2 < 4; ++c2)
#pragma unroll
                    for (int j = 0; j < 4; ++j) v[j] += t[c2][j];
            }
            f4* xo = (f4*)(XSout + (size_t)(row - MP) * DM) + lane;
#pragma unroll
            for (int j = 0; j < 4; ++j) xo[64 * j] = v[j];
        }
        float s = 0.f;
#pragma unroll
        for (int j = 0; j < 4; ++j) s += (v[j].x * v[j].x + v[j].y * v[j].y) + (v[j].z * v[j].z + v[j].w * v[j].w);
        const float rstd = rsqrtf(wave_sum(s) * (1.f / DM) + 1e-6f);
        u2* o8 = (u2*)(H + (size_t)row * DM) + lane;
#pragma unroll
        for (int j = 0; j < 4; ++j) { const f4 y = v[j] * rstd * (sc[j] + 1.f) + sh[j];
            u2 o; o.x = pkbf(y.x, y.y); o.y = pkbf(y.z, y.w); o8[64 * j] = o; }
#pragma unroll
        for (int j = 0; j < 4; ++j) { v[j] = vn[j]; sh[j] = shn[j]; sc[j] = scn[j]; }
    }
}
__device__ __forceinline__ void mgnorm_phase(const bfu* MG, bfu* OUT, const float* betaA, const float* betaL) {
    int tid_ = threadIdx.x; asm volatile("" : "+v"(tid_));
    const int lane = tid_ & 63, gw = blockIdx.x * 8 + (tid_ >> 6), NGW = gridDim.x * 8;
    const float* bp = lane < 32 ? betaA + lane * 16 : betaL + (lane - 32) * 16;
    float be[16];
#pragma unroll
    for (int e = 0; e < 4; ++e) { const f4 b = ((const f4*)bp)[e]; be[4 * e] = b.x; be[4 * e + 1] = b.y; be[4 * e + 2] = b.z; be[4 * e + 3] = b.w; }
    for (int row0 = gw; row0 < MT; row0 += 4 * NGW) {
        u4 ra[4], rb[4];
#pragma unroll
        for (int i = 0; i < 4; ++i) { const int row = row0 + i * NGW; if (row < MT) { const u4* rp = (const u4*)(MG + (size_t)row * DM + lane * 16); ra[i] = rp[0]; rb[i] = rp[1]; } }
#pragma unroll
        for (int i = 0; i < 4; ++i) { const int row = row0 + i * NGW; if (row < MT) {
            const unsigned wv[8] = {ra[i].x, ra[i].y, ra[i].z, ra[i].w, rb[i].x, rb[i].y, rb[i].z, rb[i].w};
            float f[16]; float s = 0.f;
#pragma unroll
            for (int e = 0; e < 8; ++e) { f[2 * e] = bflo(wv[e]); f[2 * e + 1] = bfhi(wv[e]); s += f[2 * e] * f[2 * e] + f[2 * e + 1] * f[2 * e + 1]; }
#pragma unroll
            for (int o = 1; o < 32; o <<= 1) s += __shfl_xor(s, o);
            const float rstd = rsqrtf(s * (1.f / 512.f) + 1e-6f);
            u4 oa, ob;
            oa.x = pkbf(f[0] * rstd * be[0], f[1] * rstd * be[1]); oa.y = pkbf(f[2] * rstd * be[2], f[3] * rstd * be[3]);
            oa.z = pkbf(f[4] * rstd * be[4], f[5] * rstd * be[5]); oa.w = pkbf(f[6] * rstd * be[6], f[7] * rstd * be[7]);
            ob.x = pkbf(f[8] * rstd * be[8], f[9] * rstd * be[9]); ob.y = pkbf(f[10] * rstd * be[10], f[11] * rstd * be[11]);
            ob.z = pkbf(f[12] * rstd * be[12], f[13] * rstd * be[13]); ob.w = pkbf(f[14] * rstd * be[14], f[15] * rstd * be[15]);
            u4* wp = (u4*)(OUT + (size_t)row * DM + lane * 16); wp[0] = oa; wp[1] = ob; } }
    }
}
__device__ __forceinline__ void fix_phase(float* XS, const float* part, int nch) {
    int tid_ = threadIdx.x; asm volatile("" : "+v"(tid_));
    const int lane = tid_ & 63, gw = blockIdx.x * 8 + (tid_ >> 6), NGW = gridDim.x * 8;
    for (int row = gw; row < MS; row += NGW) {
        f4* xr = (f4*)(XS + (size_t)row * DM) + lane; const f4* pp = (const f4*)(part + (size_t)row * DM) + lane;
        f4 v[4];
#pragma unroll
        for (int j = 0; j < 4; ++j) v[j] = xr[64 * j];
        for (int ch = 0; ch < nch; ch += 4) {
            f4 t[4][4];
#pragma unroll
            for (int c2 = 0; c2 < 4; ++c2)
#pragma unroll
                for (int j = 0; j < 4; ++j) t[c2][j] = (ch + c2 < nch) ? pp[(size_t)(ch + c2) * (1024 * 1024 / 4) + 64 * j] : (f4){0.f, 0.f, 0.f, 0.f};
#pragma unroll
            for (int c2 = 0; c2 < 4; ++c2)
#pragma unroll
                for (int j = 0; j < 4; ++j) v[j] += t[c2][j];
        }
#pragma unroll
        for (int j = 0; j < 4; ++j) xr[64 * j] = v[j];
    }
}
__device__ __forceinline__ void attn_item(int idx, const bfu* Z, const float* qg, const float* kg, const float* sinks, bfu* MG, float* outk, float* outv, unsigned char* lds) {
    int tid_ = threadIdx.x; asm volatile("" : "+v"(tid_));
    const int tid = tid_, lane = tid & 63, wave = __builtin_amdgcn_readfirstlane(tid >> 6);
    const int b = idx >> 5, nb = (idx >> 1) & 15, kvh = idx & 1, R0 = b * 2048 + nb * 128;
    bfu* Ks = (bfu*)lds;
    bfu* Vt = (bfu*)(lds + 36864);
#ifdef DBG_ZERO_LDS
    for (int i = tid; i < 70656 / 16; i += 512) ((u4*)lds)[i] = (u4){0u, 0u, 0u, 0u};
    __syncthreads();
#endif
    {
        const int kr = tid >> 1, half = tid & 1;
        const bool ok = (nb > 0) || (kr >= 128);
        u4 kw[4], vw[4];
        if (ok) { const u4* kp = (const u4*)(Z + (size_t)(R0 - 128 + kr) * INC + 512 + kvh * 64 + half * 32); const u4* vp = (const u4*)(Z + (size_t)(R0 - 128 + kr) * INC + 640 + kvh * 64 + half * 32);
#pragma unroll
            for (int e = 0; e < 4; ++e) { kw[e] = kp[e]; vw[e] = vp[e]; } }
        else {
#pragma unroll
            for (int e = 0; e < 4; ++e) { kw[e] = (u4){0u, 0u, 0u, 0u}; vw[e] = (u4){0u, 0u, 0u, 0u}; } }
        float kf[32]; float ss = 0.f;
#pragma unroll
        for (int e = 0; e < 4; ++e) { const unsigned ww[4] = {kw[e].x, kw[e].y, kw[e].z, kw[e].w};
#pragma unroll
            for (int t = 0; t < 4; ++t) { kf[8 * e + 2 * t] = bflo(ww[t]); kf[8 * e + 2 * t + 1] = bfhi(ww[t]); } }
#pragma unroll
        for (int e = 0; e < 32; ++e) ss += kf[e] * kf[e];
        ss += __shfl_xor(ss, 1);
        const float rs = rsqrtf(ss * (1.f / 64.f) + 1e-6f);
#pragma unroll
        for (int e = 0; e < 32; ++e) kf[e] = kf[e] * rs * kg[half * 32 + e];
        u4* kd = (u4*)(Ks + kr * 72 + half * 32);
#pragma unroll
        for (int e = 0; e < 4; ++e) { u4 o; o.x = pkbf(kf[8 * e], kf[8 * e + 1]); o.y = pkbf(kf[8 * e + 2], kf[8 * e + 3]); o.z = pkbf(kf[8 * e + 4], kf[8 * e + 5]); o.w = pkbf(kf[8 * e + 6], kf[8 * e + 7]); kd[e] = o; }
#pragma unroll
        for (int e = 0; e < 4; ++e) { const unsigned ww[4] = {vw[e].x, vw[e].y, vw[e].z, vw[e].w};
#pragma unroll
            for (int t = 0; t < 4; ++t) { Vt[(half * 32 + 8 * e + 2 * t) * 264 + kr] = (bfu)(ww[t] & 0xffffu); Vt[(half * 32 + 8 * e + 2 * t + 1) * 264 + kr] = (bfu)(ww[t] >> 16); } }
        if (nb == 15 && kr >= 128) {
            float* ko = outk + ((size_t)(b * 128 + kr - 128) * 2 + kvh) * 64 + half * 32; float* vo = outv + ((size_t)(b * 128 + kr - 128) * 2 + kvh) * 64 + half * 32;
#pragma unroll
            for (int e = 0; e < 8; ++e) ((f4*)ko)[e] = (f4){kf[4 * e], kf[4 * e + 1], kf[4 * e + 2], kf[4 * e + 3]};
#pragma unroll
            for (int e = 0; e < 4; ++e) { const unsigned ww[4] = {vw[e].x, vw[e].y, vw[e].z, vw[e].w};
                ((f4*)vo)[2 * e] = (f4){bflo(ww[0]), bfhi(ww[0]), bflo(ww[1]), bfhi(ww[1])}; ((f4*)vo)[2 * e + 1] = (f4){bflo(ww[2]), bfhi(ww[2]), bflo(ww[3]), bfhi(ww[3])}; }
        }
    }
    __syncthreads();
    const int q = lane & 31, hi = lane >> 5;
#pragma unroll 1
    for (int itk = 0; itk < 2; ++itk) {
        const int task = wave + 8 * itk, g = task & 3, qs = task >> 2, h = kvh * 4 + g;
        int qq = q; asm volatile("" : "+v"(qq));
        const bfu* qp = Z + (size_t)(R0 + 32 * qs + q) * INC + h * 64 + hi * 8;
        float qv[32]; float ss = 0.f;
#pragma unroll
        for (int ds = 0; ds < 4; ++ds) { const u4 raw = *(const u4*)(qp + 16 * ds); const unsigned ww[4] = {raw.x, raw.y, raw.z, raw.w};
#pragma unroll
            for (int t = 0; t < 4; ++t) { qv[8 * ds + 2 * t] = bflo(ww[t]); qv[8 * ds + 2 * t + 1] = bfhi(ww[t]); } }
#pragma unroll
        for (int e = 0; e < 32; ++e) ss += qv[e] * qv[e];
        ss += __shfl_xor(ss, 32);
        const float qsc = rsqrtf(ss * (1.f / 64.f) + 1e-6f) * 0.125f;
        s16x8 qf[4];
#pragma unroll
        for (int ds = 0; ds < 4; ++ds) { const float* gp = qg + 16 * ds + 8 * hi; u4 o;
            o.x = pkbf(qv[8 * ds] * qsc * gp[0], qv[8 * ds + 1] * qsc * gp[1]); o.y = pkbf(qv[8 * ds + 2] * qsc * gp[2], qv[8 * ds + 3] * qsc * gp[3]);
            o.z = pkbf(qv[8 * ds + 4] * qsc * gp[4], qv[8 * ds + 5] * qsc * gp[5]); o.w = pkbf(qv[8 * ds + 6] * qsc * gp[6], qv[8 * ds + 7] * qsc * gp[7]);
            qf[ds] = __builtin_bit_cast(s16x8, o); }
        const float slope = exp2f(-(float)(h + 1)), sink = sinks[h];
        const int jt0 = (nb == 0) ? 4 : qs;
        f16v S[5];
        float m = sink;
#pragma unroll
        for (int x = 0; x < 5; ++x) {
            const int jt = qs + x;
            if (jt >= jt0) {
                f16v acc;
#pragma unroll
                for (int r = 0; r < 16; ++r) acc[r] = 0.f;
#pragma unroll
                for (int ds = 0; ds < 4; ++ds) { const s16x8 a = *(const s16x8*)(Ks + (32 * jt + q) * 72 + 16 * ds + 8 * hi); acc = __builtin_amdgcn_mfma_f32_32x32x16_bf16(a, qf[ds], acc, 0, 0, 0); }
#pragma unroll
                for (int r = 0; r < 16; ++r) { const int dist = 128 + 32 * qs + qq - (32 * jt + crow(r, hi)); const bool valid = dist >= 0 && dist <= 128;
                    const float sv = valid ? acc[r] - slope * (float)dist : -1e30f; S[x][r] = sv; m = fmaxf(m, sv); }
            } else {
#pragma unroll
                for (int r = 0; r < 16; ++r) S[x][r] = -1e30f;
            }
        }
        m = fmaxf(m, __shfl_xor(m, 32));
        float l = 0.f;
#pragma unroll
        for (int x = 0; x < 5; ++x)
#pragma unroll
            for (int r = 0; r < 16; ++r) { const float pe = __expf(S[x][r] - m); S[x][r] = pe; l += pe; }
        l += __shfl_xor(l, 32);
        l += __expf(sink - m);
        const float rinv = 1.f / l;
        f16v o0, o1;
#pragma unroll
        for (int r = 0; r < 16; ++r) { o0[r] = 0.f; o1[r] = 0.f; }
#pragma unroll
        for (int x = 0; x < 5; ++x) {
            const int jt = qs + x;
            if (jt >= jt0) {
#pragma unroll
                for (int s2 = 0; s2 < 2; ++s2) {
                    u4 pa; pa.x = pkbf(S[x][8 * s2], S[x][8 * s2 + 1]); pa.y = pkbf(S[x][8 * s2 + 2], S[x][8 * s2 + 3]); pa.z = pkbf(S[x][8 * s2 + 4], S[x][8 * s2 + 5]); pa.w = pkbf(S[x][8 * s2 + 6], S[x][8 * s2 + 7]);
                    const s16x8 A = __builtin_bit_cast(s16x8, pa);
                    const bfu* vp0 = Vt + q * 264 + 32 * jt + 16 * s2 + 4 * hi; const bfu* vp1 = vp0 + 32 * 264;
                    const u2 a0 = *(const u2*)vp0, a1 = *(const u2*)(vp0 + 8), b0 = *(const u2*)vp1, b1 = *(const u2*)(vp1 + 8);
                    const u4 B0 = {a0.x, a0.y, a1.x, a1.y}, B1 = {b0.x, b0.y, b1.x, b1.y};
                    o0 = __builtin_amdgcn_mfma_f32_32x32x16_bf16(A, __builtin_bit_cast(s16x8, B0), o0, 0, 0, 0);
                    o1 = __builtin_amdgcn_mfma_f32_32x32x16_bf16(A, __builtin_bit_cast(s16x8, B1), o1, 0, 0, 0);
                }
            }
        }
        bfu* op = MG + (size_t)(R0 + 32 * qs) * DM + h * 64 + q;
#pragma unroll
        for (int r = 0; r < 16; ++r) { const int qr = crow(r, hi); const float rl = __shfl(rinv, qr);
            op[(size_t)qr * DM] = tobf(o0[r] * rl); op[(size_t)qr * DM + 32] = tobf(o1[r] * rl); }
    }
}

__device__ __forceinline__ void sattn_item(int b, const bfu* Z, const float* ck, const float* cv, const float* qg, const float* kg, const float* sinks, bfu* MG, float* outk, float* outv, unsigned char* lds) {
    int tid_ = threadIdx.x; asm volatile("" : "+v"(tid_));
    const int tid = tid_, lane = tid & 63, wave = __builtin_amdgcn_readfirstlane(tid >> 6);
    bfu* KK = (bfu*)lds;
    bfu* VV = (bfu*)(lds + 34816);
    float* QS = (float*)(lds + 69632);
    float* SC = (float*)(lds + 86016);
    const float* ckb = ck + (size_t)b * 16384; const float* cvb = cv + (size_t)b * 16384;
    float* okb = outk + (size_t)b * 16384; float* ovb = outv + (size_t)b * 16384;
#pragma unroll
    for (int it = 0; it < 8; ++it) { const int i = tid + 512 * it, row = i >> 5, c4 = (i & 31) * 4;
        const f4 k4 = ((const f4*)ckb)[i], v4 = ((const f4*)cvb)[i];
        u2 o; o.x = pkbf(k4.x, k4.y); o.y = pkbf(k4.z, k4.w); *(u2*)(KK + row * 128 + c4) = o;
        o.x = pkbf(v4.x, v4.y); o.y = pkbf(v4.z, v4.w); *(u2*)(VV + row * 128 + c4) = o;
        if (row >= 8) { ((f4*)okb)[i - 256] = k4; ((f4*)ovb)[i - 256] = v4; } }
    {
        const int pair = tid >> 5, i = pair >> 1, kvh = pair & 1, dd = (tid & 31) * 2;
        const bfu* zr = Z + (size_t)(MP + 8 * b + i) * INC;
        const unsigned kwd = *(const unsigned*)(zr + 512 + kvh * 64 + dd), vwd = *(const unsigned*)(zr + 640 + kvh * 64 + dd);
        float k0 = bflo(kwd), k1 = bfhi(kwd); float ss = k0 * k0 + k1 * k1;
#pragma unroll
        for (int o = 1; o < 32; o <<= 1) ss += __shfl_xor(ss, o);
        const float rs = rsqrtf(ss * (1.f / 64.f) + 1e-6f);
        k0 = k0 * rs * kg[dd]; k1 = k1 * rs * kg[dd + 1];
        *(unsigned*)(KK + (128 + i) * 128 + kvh * 64 + dd) = pkbf(k0, k1); *(unsigned*)(VV + (128 + i) * 128 + kvh * 64 + dd) = vwd;
        float* ko = okb + (size_t)(120 + i) * 128 + kvh * 64 + dd; ko[0] = k0; ko[1] = k1;
        float* vo = ovb + (size_t)(120 + i) * 128 + kvh * 64 + dd; vo[0] = bflo(vwd); vo[1] = bfhi(vwd);
    }
    {
        const int pair = tid >> 3, i = pair >> 3, h = pair & 7, d0 = (tid & 7) * 8;
        const u4 raw = *(const u4*)(Z + (size_t)(MP + 8 * b + i) * INC + h * 64 + d0); const unsigned ww[4] = {raw.x, raw.y, raw.z, raw.w};
        float qv[8]; float ss = 0.f;
#pragma unroll
        for (int t = 0; t < 4; ++t) { qv[2 * t] = bflo(ww[t]); qv[2 * t + 1] = bfhi(ww[t]); ss += qv[2 * t] * qv[2 * t] + qv[2 * t + 1] * qv[2 * t + 1]; }
        ss += __shfl_xor(ss, 1); ss += __shfl_xor(ss, 2); ss += __shfl_xor(ss, 4);
        const float rs = rsqrtf(ss * (1.f / 64.f) + 1e-6f) * 0.125f;
#pragma unroll
        for (int e = 0; e < 8; ++e) QS[i * 512 + h * 64 + d0 + e] = qv[e] * rs * qg[d0 + e];
    }
    __syncthreads();
    {
        const int i = lane >> 3, h = lane & 7, kvh = h >> 2;
        float qr[64];
#pragma unroll
        for (int e = 0; e < 16; ++e) { const f4 t = *(const f4*)&QS[i * 512 + h * 64 + 4 * e]; qr[4 * e] = t.x; qr[4 * e + 1] = t.y; qr[4 * e + 2] = t.z; qr[4 * e + 3] = t.w; }
        const float slope = exp2f(-(float)(h + 1));
        for (int j = wave; j < 136; j += 8) {
            const u4* kp = (const u4*)(KK + j * 128 + kvh * 64); float d = 0.f;
#pragma unroll
            for (int c = 0; c < 8; ++c) { const u4 kw = kp[c]; const unsigned ww[4] = {kw.x, kw.y, kw.z, kw.w};
#pragma unroll
                for (int t = 0; t < 4; ++t) d += qr[8 * c + 2 * t] * bflo(ww[t]) + qr[8 * c + 2 * t + 1] * bfhi(ww[t]); }
            const int dist = 128 + i - j; const bool valid = dist >= 0 && dist <= 128;
            SC[lane * 137 + j] = valid ? d - slope * (float)dist : -1e30f;
        }
    }
    __syncthreads();
    {
        const int pair = tid >> 3, sub = tid & 7, h = pair & 7; const float sink = sinks[h];
        float m = sink;
        for (int j = sub; j < 136; j += 8) m = fmaxf(m, SC[pair * 137 + j]);
        m = fmaxf(m, __shfl_xor(m, 1)); m = fmaxf(m, __shfl_xor(m, 2)); m = fmaxf(m, __shfl_xor(m, 4));
        float l = 0.f;
        for (int j = sub; j < 136; j += 8) { const float pe = __expf(SC[pair * 137 + j] - m); SC[pair * 137 + j] = pe; l += pe; }
        l += __shfl_xor(l, 1); l += __shfl_xor(l, 2); l += __shfl_xor(l, 4);
        l += __expf(sink - m);
        const float rl = 1.f / l;
        for (int j = sub; j < 136; j += 8) SC[pair * 137 + j] *= rl;
    }
    __syncthreads();
    {
        const int pair = tid >> 3, dc = tid & 7, i = pair >> 3, h = pair & 7, kvh = h >> 2;
        float acc[8];
#pragma unroll
        for (int e = 0; e < 8; ++e) acc[e] = 0.f;
        for (int j = 0; j < 136; ++j) { const float pj = SC[pair * 137 + j]; const u4 vw = *(const u4*)(VV + j * 128 + kvh * 64 + dc * 8); const unsigned ww[4] = {vw.x, vw.y, vw.z, vw.w};
#pragma unroll
            for (int t = 0; t < 4; ++t) { acc[2 * t] += pj * bflo(ww[t]); acc[2 * t + 1] += pj * bfhi(ww[t]); } }
        u4 o; o.x = pkbf(acc[0], acc[1]); o.y = pkbf(acc[2], acc[3]); o.z = pkbf(acc[4], acc[5]); o.w = pkbf(acc[6], acc[7]);
        *(u4*)(MG + (size_t)(MP + 8 * b + i) * DM + h * 64 + dc * 8) = o;
    }
}
template <bool SAMPLE>
__device__ __forceinline__ void lru_item(int idx, const bfu* Z, const float* st_conv, const float* st_lru, const float* convw, const float* convb, const float* wrg, const float* brg,
                                         const float* wig, const float* big, const float* lam, bfu* MG, float* out_conv, float* out_lru, unsigned char* lds) {
    constexpr int L = SAMPLE ? 8 : 64, NT = SAMPLE ? 1 : 32, XROWS = SAMPLE ? 88 : 67;
    int tid_ = threadIdx.x; asm volatile("" : "+v"(tid_));
    const int tid = tid_, lane = tid & 63, wave = __builtin_amdgcn_readfirstlane(tid >> 6);
    const int n = idx & 7, bb = idx >> 3;
    const int rowbase = SAMPLE ? MP + bb * 64 : bb * 2048, ch0 = n * 64;
    float* XRS = (float*)lds;
    bfu* XCB = (bfu*)(lds + 22528);
    float* XCF = (float*)(lds + 31744);
    bfu* WRT = (bfu*)(lds + 48128);
    bfu* WIT = (bfu*)(lds + 57344);
    float* AA = (float*)(lds + 66560);
    float* UU = (float*)(lds + 82944);
    bfu* GR = (bfu*)(lds + 99328);
    float* COMB = (float*)(lds + 107520);
    float* HCAR = (float*)(lds + 111616);
    {
        const int c = tid >> 3, d0 = (tid & 7) * 8;
        const f4* rp = (const f4*)(wrg + (size_t)n * 4096 + c * 64 + d0); const f4* ip = (const f4*)(wig + (size_t)n * 4096 + c * 64 + d0);
        const f4 r0 = rp[0], r1 = rp[1], i0 = ip[0], i1 = ip[1];
        const float rv[8] = {r0.x, r0.y, r0.z, r0.w, r1.x, r1.y, r1.z, r1.w}, iv[8] = {i0.x, i0.y, i0.z, i0.w, i1.x, i1.y, i1.z, i1.w};
#pragma unroll
        for (int e = 0; e < 8; ++e) { WRT[(d0 + e) * 72 + c] = tobf(rv[e]); WIT[(d0 + e) * 72 + c] = tobf(iv[e]); }
        if (tid < 64) HCAR[tid] = 0.f;
    }
    const int ct_t = tid >> 3, ct_c = (tid & 7) * 8;
    float cw[4][8], cbv[8];
#pragma unroll
    for (int e = 0; e < 8; ++e) { cbv[e] = convb[ch0 + ct_c + e];
#pragma unroll
        for (int tap = 0; tap < 4; ++tap) cw[tap][e] = convw[tap * 512 + ch0 + ct_c + e]; }
    const int fr = lane & 15, fq = lane >> 4, rt = wave >> 1;
    float g_br[2], g_bi[2], g_sp[2];
#pragma unroll
    for (int cc = 0; cc < 2; ++cc) { const int d = 16 * (2 * (wave & 1) + cc) + fr; g_br[cc] = brg[ch0 + d]; g_bi[cc] = big[ch0 + d];
        const float x = -lam[ch0 + d]; g_sp[cc] = fmaxf(x, 0.f) + log1pf(__expf(-fabsf(x))); }
    u4 pxr[2], pgr; f4 pst[2][2];
    auto prefetch = [&](int tt) {
        const int t0 = tt * 64;
#pragma unroll
        for (int k = 0; k < 2; ++k) { const int i = tid + 512 * k; pxr[k] = (u4){0u, 0u, 0u, 0u};
            if (i < XROWS * 8) { const int xrow = i >> 3, cc = (i & 7) * 8;
                if (SAMPLE) { const int seg = xrow / 11, rr = xrow % 11;
                    if (rr < 3) { const f4* sp = (const f4*)(st_conv + ((size_t)(bb * 8 + seg) * 3 + rr) * 512 + ch0 + cc); pst[k][0] = sp[0]; pst[k][1] = sp[1]; }
                    else pxr[k] = *(const u4*)(Z + (size_t)(rowbase + seg * 8 + rr - 3) * INC + 768 + ch0 + cc); }
                else { const int trel = t0 - 3 + xrow; if (trel >= 0) pxr[k] = *(const u4*)(Z + (size_t)(rowbase + trel) * INC + 768 + ch0 + cc); } } }
        pgr = *(const u4*)(Z + (size_t)(rowbase + t0 + (tid >> 3)) * INC + 1280 + ch0 + (tid & 7) * 8);
    };
    prefetch(0);
    for (int tt = 0; tt < NT; ++tt) {
        const int t0 = tt * 64;
#pragma unroll
        for (int k = 0; k < 2; ++k) { const int i = tid + 512 * k;
            if (i < XROWS * 8) { const int xrow = i >> 3, cc = (i & 7) * 8; f4 lo, hi4;
                if (SAMPLE && (xrow % 11) < 3) { lo = pst[k][0]; hi4 = pst[k][1]; }
                else { lo = (f4){bflo(pxr[k].x), bfhi(pxr[k].x), bflo(pxr[k].y), bfhi(pxr[k].y)}; hi4 = (f4){bflo(pxr[k].z), bfhi(pxr[k].z), bflo(pxr[k].w), bfhi(pxr[k].w)}; }
                *(f4*)&XRS[xrow * 64 + cc] = lo; *(f4*)&XRS[xrow * 64 + cc + 4] = hi4; } }
        *(u4*)(GR + (tid >> 3) * 64 + (tid & 7) * 8) = pgr;
        __syncthreads();
        if (tt + 1 < NT) prefetch(tt + 1);
        if (SAMPLE) {
#pragma unroll
            for (int k = 0; k < 3; ++k) { const int i = tid + 512 * k, seg = i / 192, rr = (i % 192) >> 6, c = i & 63;
                out_conv[((size_t)(bb * 8 + seg) * 3 + rr) * 512 + ch0 + c] = XRS[(seg * 11 + 8 + rr) * 64 + c]; }
        } else if (tt == NT - 1) {
            if (tid < 192) { const int rr = tid >> 6, c = tid & 63; out_conv[((size_t)bb * 3 + rr) * 512 + ch0 + c] = XRS[(64 + rr) * 64 + c]; }
        }
        {
            const int seg = ct_t / L, tl = ct_t % L, xr0 = seg * (L + 3) + tl;
            float v[8];
#pragma unroll
            for (int e = 0; e < 8; ++e) v[e] = cbv[e];
#pragma unroll
            for (int tap = 0; tap < 4; ++tap) { const f4 a = *(const f4*)&XRS[(xr0 + tap) * 64 + ct_c], b4 = *(const f4*)&XRS[(xr0 + tap) * 64 + ct_c + 4];
                v[0] += cw[tap][0] * a.x; v[1] += cw[tap][1] * a.y; v[2] += cw[tap][2] * a.z; v[3] += cw[tap][3] * a.w;
                v[4] += cw[tap][4] * b4.x; v[5] += cw[tap][5] * b4.y; v[6] += cw[tap][6] * b4.z; v[7] += cw[tap][7] * b4.w; }
            *(f4*)&XCF[ct_t * 64 + ct_c] = (f4){v[0], v[1], v[2], v[3]}; *(f4*)&XCF[ct_t * 64 + ct_c + 4] = (f4){v[4], v[5], v[6], v[7]};
            u4 o; o.x = pkbf(v[0], v[1]); o.y = pkbf(v[2], v[3]); o.z = pkbf(v[4], v[5]); o.w = pkbf(v[6], v[7]);
            *(u4*)(XCB + ct_t * 72 + ct_c) = o;
        }
        __syncthreads();
        {
            const s16x8 a0 = *(const s16x8*)(XCB + (16 * rt + fr) * 72 + 8 * fq), a1 = *(const s16x8*)(XCB + (16 * rt + fr) * 72 + 32 + 8 * fq);
#pragma unroll
            for (int cc = 0; cc < 2; ++cc) { const int ct = 2 * (wave & 1) + cc;
                const bfu* wr_ = WRT + (16 * ct + fr) * 72 + 8 * fq; const bfu* wi_ = WIT + (16 * ct + fr) * 72 + 8 * fq;
                f4 ar = {0.f, 0.f, 0.f, 0.f}, ai = {0.f, 0.f, 0.f, 0.f};
                ar = __builtin_amdgcn_mfma_f32_16x16x32_bf16(a0, *(const s16x8*)wr_, ar, 0, 0, 0); ar = __builtin_amdgcn_mfma_f32_16x16x32_bf16(a1, *(const s16x8*)(wr_ + 32), ar, 0, 0, 0);
                ai = __builtin_amdgcn_mfma_f32_16x16x32_bf16(a0, *(const s16x8*)wi_, ai, 0, 0, 0); ai = __builtin_amdgcn_mfma_f32_16x16x32_bf16(a1, *(const s16x8*)(wi_ + 32), ai, 0, 0, 0);
                const int d = 16 * ct + fr;
#pragma unroll
                for (int e = 0; e < 4; ++e) { const int t = 16 * rt + 4 * fq + e; const float xc = XCF[t * 64 + d];
                    const float r = sigm(ar[e] + g_br[cc]), gi = sigm(ai[e] + g_bi[cc]);
                    const float la = -8.f * r * g_sp[cc]; const float a = __expf(la); const float u = __builtin_amdgcn_sqrtf(fmaxf(1.f - a * a, 0.f)) * gi * xc;
                    AA[t * 64 + d] = a; UU[t * 64 + d] = u; }
            }
        }
        __syncthreads();
        float hl[8], pl[8];
        {
            float h = 0.f, P = 1.f;
#pragma unroll
            for (int i = 0; i < 8; ++i) { const float a = AA[(8 * wave + i) * 64 + lane], u = UU[(8 * wave + i) * 64 + lane]; h = a * h + u; P *= a; hl[i] = h; pl[i] = P; }
            if (!SAMPLE) { COMB[(wave * 64 + lane) * 2] = P; COMB[(wave * 64 + lane) * 2 + 1] = h; }
        }
        if (!SAMPLE) __syncthreads();
        float carry;
        if (SAMPLE) carry = st_lru[(size_t)(bb * 8 + wave) * 512 + ch0 + lane];
        else { carry = HCAR[lane];
            float cp[7], chh[7];
#pragma unroll
            for (int s = 0; s < 7; ++s) { cp[s] = COMB[(s * 64 + lane) * 2]; chh[s] = COMB[(s * 64 + lane) * 2 + 1]; }
#pragma unroll
            for (int s = 0; s < 7; ++s) carry = (s < wave) ? cp[s] * carry + chh[s] : carry; }
        float hfin = 0.f;
#pragma unroll
        for (int i = 0; i < 8; ++i) { const int t = 8 * wave + i; const float h = hl[i] + pl[i] * carry; hfin = h;
            const float gr = bf1(GR[t * 64 + lane]);
            MG[(size_t)(rowbase + t0 + t) * DM + 512 + ch0 + lane] = tobf(h * gelu_tanh(gr)); }
        if (SAMPLE) out_lru[(size_t)(bb * 8 + wave) * 512 + ch0 + lane] = hfin;
        else if (tt == NT - 1 && wave == 7) out_lru[(size_t)bb * 512 + ch0 + lane] = hfin;
        __syncthreads();
        if (!SAMPLE && wave == 7) HCAR[lane] = hfin;
    }
}
#define LAS __attribute__((address_space(3)))
#define XB_TMO      128
#define XB_XCNT(j)  (256  + 64 * (j))
#define XB_XSUB(j)  (1280 + 64 * (j))
#define XB_XGEN(j)  (2304 + 64 * (j))
#define XB_TOP      3328
#define XB_TOPGEN   3392
#define XCD_BAR_WORDS 3456
#define XB_SPIN_CAP (1u << 18)

__device__ __forceinline__ unsigned xb_ld(unsigned* p)              { return __hip_atomic_load(p, __ATOMIC_RELAXED, __HIP_MEMORY_SCOPE_AGENT); }
__device__ __forceinline__ unsigned xb_add(unsigned* p, unsigned v) { return __hip_atomic_fetch_add(p, v, __ATOMIC_RELAXED, __HIP_MEMORY_SCOPE_AGENT); }
__device__ __forceinline__ unsigned xb_xcc_id() { return (unsigned)__builtin_amdgcn_s_getreg((3 << 11) | 20) & 0xFu; }
#define XB_SPIN(cond, bar) do { unsigned _sp = 0; while (cond) { __builtin_amdgcn_s_sleep(1); \
    if ((++_sp & 255u) == 0u) { if (xb_ld(&(bar)[XB_TMO])) break; if (_sp > XB_SPIN_CAP) { atomicAdd(&(bar)[XB_TMO], 1u); break; } } } } while (0)

struct XcdBarrier {
    unsigned* bar; unsigned x;
    volatile LAS unsigned* st;
};

__device__ __forceinline__ XcdBarrier xcd_barrier_post(unsigned* bar, volatile LAS unsigned* st) {
    XcdBarrier b; b.bar = bar; b.x = xb_xcc_id(); b.st = st;
    if (threadIdx.x == 0) (void)xb_add(&bar[XB_XCNT(b.x)], 1u);
    return b;
}
__device__ __forceinline__ void xcd_barrier_complete(unsigned* bar, unsigned x, unsigned& nloc, unsigned& nx) {
    const unsigned G = gridDim.x * gridDim.y * gridDim.z;
    unsigned sum, cnt, mine, sp = 0u;
    for (;;) {
        sum = 0u; cnt = 0u; mine = 0u;
#pragma unroll
        for (unsigned j = 0; j < 16; ++j) { const unsigned c = xb_ld(&bar[XB_XCNT(j)]); sum += c; cnt += (c > 0u) ? 1u : 0u; mine = (j == x) ? c : mine; }
        if (sum == G) break;
        __builtin_amdgcn_s_sleep(1);
        if ((++sp & 255u) == 0u) { if (xb_ld(&bar[XB_TMO])) break; if (sp > XB_SPIN_CAP) { atomicAdd(&bar[XB_TMO], 1u); break; } }
    }
    nloc = mine > 0u ? mine : 1u; nx = cnt > 0u ? cnt : 1u;
}

__device__ __forceinline__ void xcd_barrier(const XcdBarrier& b) {
    asm volatile("s_waitcnt vmcnt(0)" ::: "memory");
    __syncthreads();
    if (threadIdx.x == 0) {
        unsigned* bar = b.bar;
        __builtin_amdgcn_s_waitcnt(0);
        unsigned nloc = b.st[0], nx = b.st[1];
        if (nloc == 0u) { xcd_barrier_complete(bar, b.x, nloc, nx); b.st[0] = nloc; b.st[1] = nx; }
        const unsigned old = xb_add(&bar[XB_XSUB(b.x)], 1u);
        const unsigned gen = old / nloc;
        if (old + 1u == (gen + 1u) * nloc) {
            __builtin_amdgcn_fence(__ATOMIC_RELEASE, "agent");
            asm volatile("s_waitcnt vmcnt(0)" ::: "memory");
            const unsigned og = xb_add(&bar[XB_TOP], 1u);
            const unsigned tg = og / nx;
            if (og + 1u == (tg + 1u) * nx) xb_add(&bar[XB_TOPGEN], 1u);
            else XB_SPIN(xb_ld(&bar[XB_TOPGEN]) == tg, bar);
            __builtin_amdgcn_fence(__ATOMIC_ACQUIRE, "agent");
            xb_add(&bar[XB_XGEN(b.x)], 1u);
            asm volatile("s_waitcnt vmcnt(0)" ::: "memory");
        } else {
            XB_SPIN(xb_ld(&bar[XB_XGEN(b.x)]) == gen, bar);
            __builtin_amdgcn_fence(__ATOMIC_ACQUIRE, "agent");
            asm volatile("s_waitcnt vmcnt(0)" ::: "memory");
        }
    }
    __syncthreads();
}
#ifndef MXMASK
#define MXMASK 15
#endif
constexpr int MX_C = 128, MX_A = 512, MX_B = 128, MX_D = 128, MX_ALL = MX_C + MX_A + MX_B + MX_D;
__device__ __forceinline__ void mixer_phase(const Params& p, int l, unsigned char* lds, unsigned* ctr, volatile int* slot, int imask = 15) {
    const bfu* Z = (const bfu*)(p.ws + WS_ACT); bfu* MG = (bfu*)(p.ws + WS_MG);
    const float* qg = p.in[14] + l * 64; const float* kg = p.in[15] + l * 64; const float* sinks = p.in[16] + l * 8;
    const float* convw = p.in[17] + l * 2048; const float* convb = p.in[18] + l * 512;
    const float* wrg = p.in[19] + (size_t)l * 32768; const float* brg = p.in[20] + l * 512; const float* wig = p.in[21] + (size_t)l * 32768; const float* big = p.in[22] + l * 512;
    const float* lam = p.in[23] + l * 512;
    float* out = p.out;
    int cur = wq_next(ctr, slot);
    while (cur < MX_ALL) {
        unsigned pre = 0u;
        if (threadIdx.x == 0) pre = atomicAdd(ctr, 1u);
        int it = cur;
        if (it < MX_C) { if (imask & 1) lru_item<false>(it, Z, nullptr, nullptr, convw, convb, wrg, brg, wig, big, lam, MG, out + O_CP + (size_t)l * 16 * 1536, out + O_LP + (size_t)l * 16 * 512, lds); }
        else if ((it -= MX_C) < MX_A) { if (imask & 2) attn_item(it, Z, qg, kg, sinks, MG, out + O_KP + (size_t)l * 262144, out + O_VP + (size_t)l * 262144, lds); }
        else if ((it -= MX_A) < MX_B) { if (imask & 4) sattn_item(it, Z, p.in[2] + (size_t)l * 2097152, p.in[3] + (size_t)l * 2097152, qg, kg, sinks, MG, out + O_KS + (size_t)l * 2097152, out + O_VS + (size_t)l * 2097152, lds); }
        else { it -= MX_B; if (imask & 8) lru_item<true>(it, Z, p.in[4] + (size_t)l * 128 * 1536, p.in[5] + (size_t)l * 128 * 512, convw, convb, wrg, brg, wig, big, lam, MG, out + O_CS + (size_t)l * 128 * 1536, out + O_LS + (size_t)l * 128 * 512, lds); }
        __syncthreads();
        if (threadIdx.x == 0) *slot = (int)pre;
        __syncthreads();
        cur = *slot;
    }
}

__device__ __forceinline__ void grid_barrier(cg::grid_group& grid) {
    asm volatile("s_waitcnt vmcnt(0) lgkmcnt(0)" ::: "memory");
    __syncthreads();
    grid.sync();
    __builtin_amdgcn_fence(__ATOMIC_ACQUIRE, "agent");
    asm volatile("s_waitcnt vmcnt(0)" ::: "memory");
    __syncthreads();
}
#ifndef PH_HI
#define PH_HI 1000
#endif
#ifndef N_PHASES_CUT
#define N_PHASES_CUT 0
#endif
__global__ void __launch_bounds__(512, 2) fwd_kernel(Params p, int ph_lo, int ph_hi) {
    extern __shared__ __attribute__((aligned(16))) unsigned char lds[];
    cg::grid_group grid = cg::this_grid();
    volatile int* slot = (volatile int*)(lds + 131072);
    PG8_LAS unsigned char* lds3 = (PG8_LAS unsigned char*)lds;
    unsigned* ctl = (unsigned*)(p.ws + WS_CTL);
    const bfu* wsW = (const bfu*)(p.ws + WS_W); const float* mod = (const float*)(p.ws + WS_MOD);
    bfu* H = (bfu*)(p.ws + WS_H); bfu* MG = (bfu*)(p.ws + WS_MG); bfu* ACT = (bfu*)(p.ws + WS_ACT);
    float* X = p.out;
    const int G = gridDim.x, bx = blockIdx.x;
    if (threadIdx.x < 2) ((volatile LAS unsigned*)(lds3 + 131072 + 64))[threadIdx.x] = 0u;
    __syncthreads();
    const XcdBarrier xb = xcd_barrier_post(ctl + 4096, (volatile LAS unsigned*)(lds3 + 131072 + 64));
#define SEAM() do { if (ph_hi < 0) grid_barrier(grid); else xcd_barrier(xb); } while (0)
    int ph = 0;
#ifndef PHMASK
#define PHMASK 0xff
#endif
#ifndef DBG_IMASK
#define DBG_IMASK 1
#endif
#ifndef REPMASK
#define REPMASK 0
#endif
#define PHASE(id, ...) do { if (ph >= ph_lo && ph < ph_hi) { if constexpr ((PHMASK >> id) & 1) { const int nrep_ = ((REPMASK >> id) & 1) ? 2 : 1; \
    for (int rep_ = 0; rep_ < nrep_; ++rep_) { __VA_ARGS__; if (rep_ + 1 < nrep_) SEAM(); } } if (ph + 1 < ph_hi) SEAM(); } ++ph; } while (0)
    PHASE(0, prologue_phase(p, lds, ctl + 512 * rep_, slot));
    PHASE(7, { pg8::Gemm g{(const bfu*)(p.ws + WS_SC), (const bfu*)(p.ws + WS_WADA), 256, 2 * NMODC, 1024}; pg8::StaticOrder S; S.init(256, 2 * NMODC, G, bx);
               pg8::EpiMod E{(float*)(p.ws + WS_MOD), p.in[9]}; pg8::gemm_phase<pg8::EpiMod, pg8::StaticOrder, true, true>(lds3, g, S, E); });
    float* XS = X + (size_t)MP * DM; float* PART = (float*)(p.ws + 404 * MiB);
    bfu* XB = (bfu*)(p.ws + 448 * MiB);
    PHASE(1, norm_phase(p.in[0], p.in[1], mod, 0, 1, H, nullptr, 0, nullptr, nullptr));
    for (int l = 0; l < 2; ++l) {
        const bfu* wl = wsW + (size_t)l * W_LAYER; const float* modl = mod + (size_t)l * NCB * NMODC;
        const float* xP = l == 0 ? p.in[0] : X; const float* xS = l == 0 ? p.in[1] : XS;
        PHASE(2, { pg8::Gemm g{H, wl + W_UP1, MT, 5632, 1024}; pg8::StaticOrder S; S.init(MT, 5632, G, bx); pg8::EpiSwiglu E{ACT, DFF};
                pg8::gemm_phase<pg8::EpiSwiglu, pg8::StaticOrder, true, true>(lds3, g, S, E); });
        if (l == 0) PHASE(3, { pg8::Gemm g{ACT, wl + W_DN1, MT, 1024, DFF}; pg8::SplitOrder S; S.init(1024, DFF, G, bx); pg8::EpiResid<0> E{p.in[0], nullptr, nullptr, XB, modl + 2 * DM, 0.5f, PART};
                pg8::gemm_phase<pg8::EpiResid<0>, pg8::SplitOrder, true, true>(lds3, g, S, E); });
        else PHASE(3, { pg8::Gemm g{ACT, wl + W_DN1, MT, 1024, DFF}; pg8::SplitOrder S; S.init(1024, DFF, G, bx); pg8::EpiResid<1> E{nullptr, XB, nullptr, XB, modl + 2 * DM, 0.5f, PART};
                pg8::gemm_phase<pg8::EpiResid<1>, pg8::SplitOrder, true, true>(lds3, g, S, E); });
        PHASE(1, norm_phase(X, xS, modl, 3, 4, H, PART, DFF / 256, XS, XB));
        PHASE(4, { pg8::Gemm g{H, wl + W_IN, MT, INC, 1024}; pg8::StaticOrder S; S.init(MT, INC, G, bx); pg8::EpiPlainBf16 E{ACT, INC};
                pg8::gemm_phase<pg8::EpiPlainBf16, pg8::StaticOrder, true, true>(lds3, g, S, E); });
        PHASE(5, mixer_phase(p, l, lds, ctl + 64 * (1 + l) + 512 * rep_, slot, rep_ ? DBG_IMASK : 15));
        PHASE(6, mgnorm_phase(MG, MG, p.in[24] + l * 512, p.in[25] + l * 512));
        PHASE(3, { pg8::Gemm g{MG, wl + W_OUT, MT, 1024, 1024}; pg8::SplitOrder S; S.init(1024, 1024, G, bx); pg8::EpiResid<1> E{nullptr, XB, nullptr, XB, modl + 5 * DM, 1.0f, PART};
                pg8::gemm_phase<pg8::EpiResid<1>, pg8::SplitOrder, true, true>(lds3, g, S, E); });
        PHASE(1, norm_phase(X, XS, modl, 6, 7, H, PART, 4, XS, XB));
        PHASE(2, { pg8::Gemm g{H, wl + W_UP2, MT, 5632, 1024}; pg8::StaticOrder S; S.init(MT, 5632, G, bx); pg8::EpiSwiglu E{ACT, DFF};
                pg8::gemm_phase<pg8::EpiSwiglu, pg8::StaticOrder, true, true>(lds3, g, S, E); });
        if (l == 0) PHASE(3, { pg8::Gemm g{ACT, wl + W_DN2, MT, 1024, DFF}; pg8::SplitOrder S; S.init(1024, DFF, G, bx); pg8::EpiResid<1> E{nullptr, XB, nullptr, XB, modl + 8 * DM, 0.5f, PART};
                pg8::gemm_phase<pg8::EpiResid<1>, pg8::SplitOrder, true, true>(lds3, g, S, E); });
        else PHASE(3, { pg8::Gemm g{ACT, wl + W_DN2, MT, 1024, DFF}; pg8::SplitOrder S; S.init(1024, DFF, G, bx); pg8::EpiResid<2> E{nullptr, XB, X, nullptr, modl + 8 * DM, 0.5f, PART};
                pg8::gemm_phase<pg8::EpiResid<2>, pg8::SplitOrder, true, true>(lds3, g, S, E); });
        if (l == 0) PHASE(1, norm_phase(X, XS, mod + (size_t)NCB * NMODC, 0, 1, H, PART, DFF / 256, XS, XB));
        else PHASE(1, fix_phase(XS, PART, DFF / 256));
    }
#undef PHASE
}

extern "C" void kernel_launch(void* const* d_in, const int* in_sizes, int n_in, void* d_out, int out_size, void* d_ws, size_t ws_size, hipStream_t stream) {
    static int grid = 0;
    if (grid == 0) {
        if (n_in != 30 || ws_size < 512 * MiB) { fprintf(stderr, "kernel_launch: unexpected n_in %d / ws %zu\n", n_in, ws_size); grid = -1; return; }
        int dev = 0, cus = 0, per_cu = 0;
        hipGetDevice(&dev); hipDeviceGetAttribute(&cus, hipDeviceAttributeMultiprocessorCount, dev);
        if (hipFuncSetAttribute((const void*)fwd_kernel, hipFuncAttributeMaxDynamicSharedMemorySize, LDS_BYTES) != hipSuccess) { fprintf(stderr, "kernel_launch: hipFuncSetAttribute failed\n"); grid = -1; return; }
        hipOccupancyMaxActiveBlocksPerMultiprocessor(&per_cu, (const void*)fwd_kernel, 512, LDS_BYTES);
        if (per_cu < 1) { fprintf(stderr, "kernel_launch: occupancy query says %d\n", per_cu); per_cu = 1; }
        (void)hipGetLastError();
        grid = cus * 1;
    }
    if (grid < 0) return;
    hipMemsetAsync((char*)d_ws + WS_CTL, 0, 32768, stream);
    Params p{};
    for (int i = 0; i < 30; ++i) p.in[i] = (const float*)d_in[i];
    p.out = (float*)d_out; p.ws = (unsigned char*)d_ws;
    int lo = 0, hi = PH_HI;
    void* args[] = {&p, &lo, &hi};
    hipError_t e = hipLaunchCooperativeKernel((const void*)fwd_kernel, dim3(grid), dim3(512), args, LDS_BYTES, stream);
    if (e != hipSuccess) fprintf(stderr, "cooperative launch failed: %s (grid %d)\n", hipGetErrorString(e), grid);
}
```

```cpp
#include <hip/hip_runtime.h>
#include <hip/hip_cooperative_groups.h>
#include <cstdio>
#include <cstdint>
namespace cg = cooperative_groups;
namespace pg8 {
#define PG8_LAS __attribute__((address_space(3)))
typedef unsigned short bf16_t;
typedef short bf16x8 __attribute__((ext_vector_type(8)));
typedef float f32x4 __attribute__((ext_vector_type(4)));
typedef unsigned u32x4 __attribute__((ext_vector_type(4)));
typedef unsigned u32x2 __attribute__((ext_vector_type(2)));
constexpr int BM = 256, BK = 64, HALF = 128, HTB = HALF * BK * 2  , STAGE_BYTES = 8 * HTB, NXCD = 8, WGM = 8;

__host__ __device__ __forceinline__ int lds_byte(int r, int c) { const int st = (r >> 4) * 2 + (c >> 5), rr = r & 15, cc = c & 31, ob = rr * 64 + cc * 2; return st * 1024 + (ob ^ (((ob >> 9) & 1) << 5)); }
__host__ __device__ __forceinline__ void stage_rc(int b, int& R, int& C) { const int st = b / 1024, sb = b % 1024, swz = sb ^ (((sb >> 9) & 1) << 5); R = (st >> 1) * 16 + swz / 64; C = (st & 1) * 32 + (swz % 64) / 2; }
__host__ __device__ __forceinline__ int perm32(int rho) { const int n = rho >> 4, i = rho & 15; return 8 * (i >> 2) + 4 * n + (i & 3); }

struct Unit { int pm, pn, k0, nt; };
struct Gemm { const bf16_t* A; const bf16_t* Bt; int M, N, K; };

struct StaticOrder {
    int nM, nN, nwg, G, c;
    __host__ __device__ void init(int M, int N, int G_, int c_) { nM = M / BM; nN = N / BM; nwg = nM * nN; G = G_; c = c_; }
    __host__ __device__ bool next(int i, Unit& u) const {
        const long L = (long)i * G + c; if (L >= nwg) return false;
        int wgid = (int)L; { const int q = nwg / NXCD, r = nwg % NXCD, xcd = wgid % NXCD, off = wgid / NXCD; wgid = (xcd < r ? xcd * (q + 1) : r * (q + 1) + (xcd - r) * q) + off; }
        const int nig = WGM * nN, gid = wgid / nig, fm = gid * WGM, gsz = (nM - fm) < WGM ? (nM - fm) : WGM;
        u.pm = fm + ((wgid % nig) % gsz); u.pn = (wgid % nig) / gsz; u.k0 = 0; u.nt = 0; return true;
    }
    __device__ __forceinline__ void a_ready(const Unit&) const {}
    __device__ __forceinline__ void done(const Unit&) const {}
};
struct SplitOrder {
    StaticOrder so; int nfull, nch, nN, G, c;
    __host__ __device__ void init(int N, int K, int G_, int c_) { so.init(128 * BM, N, G_, c_); nN = N / BM; nfull = 128 * nN; nch = K / 256; G = G_; c = c_; }
    __host__ __device__ bool next(int i, Unit& u) const {
        const long L = (long)i * G + c;
        if (L < nfull) { const int nr = nfull / G; return so.next((nr * G == nfull && i < nr) ? nr - 1 - i : i, u); }
        const int j = (int)(L - nfull); if (j >= 4 * nN * nch) return false;
        const int ch = j / (4 * nN), rem = j % (4 * nN);
        u.pm = 128 + rem / nN; u.pn = rem % nN; u.k0 = 4 * ch; u.nt = 4; return true;
    }
    __device__ __forceinline__ void a_ready(const Unit&) const {}
    __device__ __forceinline__ void done(const Unit&) const {}
};


__device__ __forceinline__ unsigned cvt_pk_bf16(float lo, float hi) { unsigned r; asm volatile("v_cvt_pk_bf16_f32 %0, %1, %2" : "=v"(r) : "v"(lo), "v"(hi)); return r; }
typedef float f32x2 __attribute__((ext_vector_type(2)));
constexpr int MP_ROWS = 32768;
#ifndef RESID_GB
#define RESID_GB 4
#endif
struct EpiSwiglu {
    static constexpr bool PERM = true, AFTER_DRAIN = false;
    bf16_t* O; int ldc;
    __device__ __forceinline__ void operator()(const f32x4 (&acc)[2][2][4][2], const Unit& u, int wr, int wc, int fr, int fq) const {
        const int row0 = u.pm * BM + wr * 64 + fr, col0 = u.pn * 128 + wc * 32 + 8 * fq;
#pragma unroll
        for (int ai = 0; ai < 2; ++ai)
#pragma unroll
            for (int m = 0; m < 4; ++m) {
                bf16_t* p = O + (size_t)(row0 + ai * HALF + m * 16) * ldc + col0;
                float v[8];
#pragma unroll
                for (int n = 0; n < 2; ++n)
#pragma unroll
                    for (int e = 0; e < 4; ++e) { const float g = acc[ai][0][m][n][e], up = acc[ai][1][m][n][e];
                        v[n * 4 + e] = g * up * __builtin_amdgcn_rcpf(1.f + __expf(-g)); }
                u32x4 w; w.x = cvt_pk_bf16(v[0], v[1]); w.y = cvt_pk_bf16(v[2], v[3]); w.z = cvt_pk_bf16(v[4], v[5]); w.w = cvt_pk_bf16(v[6], v[7]);
                *(u32x4*)p = w;
            }
    }
};
struct EpiPlainBf16 {
    static constexpr bool PERM = true, AFTER_DRAIN = false;
    bf16_t* O; int ldc;
    __device__ __forceinline__ void operator()(const f32x4 (&acc)[2][2][4][2], const Unit& u, int wr, int wc, int fr, int fq) const {
        const int row0 = u.pm * BM + wr * 64 + fr, col0 = u.pn * BM + wc * 32 + 8 * fq;
#pragma unroll
        for (int ai = 0; ai < 2; ++ai)
#pragma unroll
            for (int m = 0; m < 4; ++m) {
                bf16_t* p = O + (size_t)(row0 + ai * HALF + m * 16) * ldc + col0;
#pragma unroll
                for (int bj = 0; bj < 2; ++bj) { const f32x4 v0 = acc[ai][bj][m][0], v1 = acc[ai][bj][m][1];
                    u32x4 w; w.x = cvt_pk_bf16(v0[0], v0[1]); w.y = cvt_pk_bf16(v0[2], v0[3]); w.z = cvt_pk_bf16(v1[0], v1[1]); w.w = cvt_pk_bf16(v1[2], v1[3]);
                    *(u32x4*)(p + bj * HALF) = w; }
            }
    }
};
template <int MODE> struct EpiResid {
    static constexpr bool PERM = false, AFTER_DRAIN = false;
    const float* resF; const bf16_t* resB; float* outF; bf16_t* outB; const float* gate; float coef; float* part;
    __device__ __forceinline__ void operator()(const f32x4 (&acc)[2][2][4][2], const Unit& u, int wr, int wc, int fr, int fq) const {
        const int row0 = u.pm * BM + wr * 64 + fr, col0 = u.pn * BM + wc * 32 + 4 * fq;
        if (u.nt != 0) {
            float* pb = part + (size_t)(u.k0 >> 2) * 1024 * 1024;
#pragma unroll
            for (int aim = 0; aim < 4; ++aim) { const int ai = aim >> 1, m0 = (aim & 1) * 2;
                f32x4 g[4][2][2];
#pragma unroll
                for (int m = m0; m < m0 + 2; ++m) { const int row = row0 + ai * HALF + m * 16 - MP_ROWS; const float* gp = gate + (size_t)(16 + (row >> 3)) * 9216 + col0;
#pragma unroll
                    for (int bj = 0; bj < 2; ++bj)
#pragma unroll
                        for (int n = 0; n < 2; ++n) g[m][bj][n] = *(const f32x4*)(gp + bj * HALF + n * 16); }
                asm volatile("" ::: "memory");
#pragma unroll
                for (int m = m0; m < m0 + 2; ++m) { const int row = row0 + ai * HALF + m * 16 - MP_ROWS; float* op = pb + (size_t)row * 1024 + col0;
#pragma unroll
                    for (int bj = 0; bj < 2; ++bj)
#pragma unroll
                        for (int n = 0; n < 2; ++n) *(f32x4*)(op + bj * HALF + n * 16) = (g[m][bj][n] * coef) * acc[ai][bj][m][n]; }
                asm volatile("" ::: "memory");
            }
            return;
        }
        const float* gp = gate + (size_t)(u.pm >> 3) * 9216 + col0;
        f32x4 gc[2][2];
#pragma unroll
        for (int bj = 0; bj < 2; ++bj)
#pragma unroll
            for (int n = 0; n < 2; ++n) gc[bj][n] = *(const f32x4*)(gp + bj * HALF + n * 16);
        asm volatile("" ::: "memory");
#pragma unroll
        for (int bj = 0; bj < 2; ++bj)
#pragma unroll
            for (int n = 0; n < 2; ++n) gc[bj][n] = gc[bj][n] * coef;
        constexpr int GB = (MODE == 0) ? 2 : RESID_GB;
#pragma unroll
        for (int g0 = 0; g0 < 8; g0 += GB) {
            f32x4 r[8][2][2]; u32x2 rb[8][2][2];
#pragma unroll
            for (int gi = g0; gi < g0 + GB; ++gi) { const int ai = gi >> 2, m = gi & 3; const size_t off = (size_t)(row0 + ai * HALF + m * 16) * 1024 + col0;
#pragma unroll
                for (int bj = 0; bj < 2; ++bj)
#pragma unroll
                    for (int n = 0; n < 2; ++n) { if (MODE == 0) r[gi][bj][n] = *(const f32x4*)(resF + off + bj * HALF + n * 16); else rb[gi][bj][n] = *(const u32x2*)(resB + off + bj * HALF + n * 16); } }
            asm volatile("" ::: "memory");
#pragma unroll
            for (int gi = g0; gi < g0 + GB; ++gi) { const int ai = gi >> 2, m = gi & 3; const size_t off = (size_t)(row0 + ai * HALF + m * 16) * 1024 + col0;
#pragma unroll
                for (int bj = 0; bj < 2; ++bj)
#pragma unroll
                    for (int n = 0; n < 2; ++n) {
                        f32x4 x;
                        if (MODE == 0) x = r[gi][bj][n];
                        else { const u32x2 w = rb[gi][bj][n]; x = (f32x4){__uint_as_float(w.x << 16), __uint_as_float(w.x & 0xffff0000u), __uint_as_float(w.y << 16), __uint_as_float(w.y & 0xffff0000u)}; }
                        const f32x4 o = x + gc[bj][n] * acc[ai][bj][m][n];
                        if (MODE == 2) *(f32x4*)(outF + off + bj * HALF + n * 16) = o;
                        else { u32x2 w; w.x = cvt_pk_bf16(o[0], o[1]); w.y = cvt_pk_bf16(o[2], o[3]); *(u32x2*)(outB + off + bj * HALF + n * 16) = w; } } }
            asm volatile("" ::: "memory");
        }
    }
};
struct EpiMod {
    static constexpr bool PERM = false, AFTER_DRAIN = false;
    float* mod; const float* bada;
    __device__ __forceinline__ void operator()(const f32x4 (&acc)[2][2][4][2], const Unit& u, int wr, int wc, int fr, int fq) const {
        const int row0 = wr * 64 + fr, n0 = u.pn * BM + wc * 32 + 4 * fq, l = n0 / 9216, j0 = n0 - l * 9216;
        f32x4 bv[2][2];
#pragma unroll
        for (int bj = 0; bj < 2; ++bj)
#pragma unroll
            for (int n = 0; n < 2; ++n) bv[bj][n] = *(const f32x4*)(bada + (size_t)l * 9216 + j0 + bj * HALF + n * 16);
        asm volatile("" ::: "memory");
#pragma unroll
        for (int ai = 0; ai < 2; ++ai)
#pragma unroll
            for (int m = 0; m < 4; ++m) {
                const int row = row0 + ai * HALF + m * 16;
                if (row < 144) {
                    float* op = mod + ((size_t)l * 144 + row) * 9216 + j0;
#pragma unroll
                    for (int bj = 0; bj < 2; ++bj)
#pragma unroll
                        for (int n = 0; n < 2; ++n) { const int c = bj * HALF + n * 16; *(f32x4*)(op + c) = acc[ai][bj][m][n] + bv[bj][n]; }
                }
            }
    }
};
template <class Epi, class Sched, bool ALIGN_EPI = false, bool SP2 = false>
__device__ __forceinline__ void gemm_phase(PG8_LAS unsigned char* lds, const Gemm g, const Sched& S, const Epi& E) {
    int tid_ = threadIdx.x; asm volatile("" : "+v"(tid_));
    const int tid = tid_, wid = __builtin_amdgcn_readfirstlane(tid >> 6), lane = tid & 63, wr = wid >> 2, wc = wid & 3, fr = lane & 15, fq = lane >> 4;
    const int K = g.K, ntf = K / BK;
    unsigned voffA[2], voffB[2];
#pragma unroll
    for (int i = 0; i < 2; ++i) { int R, C; stage_rc(tid * 16 + i * 8192, R, C); const int Rb = Epi::PERM ? ((R & ~31) + perm32(R & 31)) : R;
        voffA[i] = (unsigned)(R * K + C) * 2u; voffB[i] = (unsigned)(Rb * K + C) * 2u; }
    const size_t kstep = (size_t)(BK * 2);
    const size_t hstep = (size_t)HALF * K * 2;
    const size_t tstep = 2 * hstep;
    const unsigned ldsw = (unsigned)wid * 1024u;
    const int aoff = lds_byte(wr * 64 + fr, fq * 8), boff = lds_byte(wc * 32 + fr, fq * 8);
#define PG8_SA(b, h) (((b) * 2 + (h)) * HTB)
#define PG8_SB(b, h) ((4 + (b) * 2 + (h)) * HTB)
#define PG8_STAGE(bufoff, gbase, voff) do { _Pragma("unroll") for (int _i = 0; _i < 2; ++_i) \
        __builtin_amdgcn_global_load_lds((const unsigned*)((const char*)(gbase) + (voff)[_i]), (PG8_LAS unsigned*)(lds + (bufoff) + ldsw + _i * 8192), 16, 0, 0); } while (0)
#define PG8_LDA(dst, b, h) do { _Pragma("unroll") for (int m = 0; m < 4; ++m) _Pragma("unroll") for (int k = 0; k < 2; ++k) dst[m][k] = *(const PG8_LAS bf16x8*)(lds + PG8_SA(b, h) + aoff + m * 2048 + k * 1024); } while (0)
#define PG8_LDB(dst, b, h) do { _Pragma("unroll") for (int n = 0; n < 2; ++n) _Pragma("unroll") for (int k = 0; k < 2; ++k) dst[n][k] = *(const PG8_LAS bf16x8*)(lds + PG8_SB(b, h) + boff + n * 2048 + k * 1024); } while (0)
#define PG8_MMA(ai, bj, At, Bt) do { __builtin_amdgcn_s_setprio(1); _Pragma("unroll") for (int m = 0; m < 4; ++m) _Pragma("unroll") for (int n = 0; n < 2; ++n) _Pragma("unroll") for (int k = 0; k < 2; ++k) \
        acc[ai][bj][m][n] = __builtin_amdgcn_mfma_f32_16x16x32_bf16(Bt[n][k], At[m][k], acc[ai][bj][m][n], 0, 0, 0); __builtin_amdgcn_s_setprio(0); } while (0)
#define PG8_WAIT_V(n) asm volatile("s_waitcnt vmcnt(" #n ")" ::: "memory")
#define PG8_WAIT_L(n) asm volatile("s_waitcnt lgkmcnt(" #n ")" ::: "memory")
#define PG8_BAR __builtin_amdgcn_s_barrier()
#define PG8_SCHED __builtin_amdgcn_sched_barrier(0)
    Unit cur, nxt; int ui = 0;
    if (!S.next(0, cur)) return;
    f32x4 acc[2][2][4][2];
#pragma unroll
    for (int a = 0; a < 2; ++a)
#pragma unroll
        for (int b = 0; b < 2; ++b)
#pragma unroll
            for (int m = 0; m < 4; ++m)
#pragma unroll
                for (int n = 0; n < 2; ++n) acc[a][b][m][n] = (f32x4){0.f, 0.f, 0.f, 0.f};
    bf16x8 At[4][2], B0[2][2], B1[2][2];
    int nt = cur.nt ? cur.nt : ntf;
    const char* cA = (const char*)g.A + (size_t)cur.pm * tstep + (size_t)cur.k0 * kstep; const char* cB = (const char*)g.Bt + (size_t)cur.pn * tstep + (size_t)cur.k0 * kstep;
    S.a_ready(cur);
    if constexpr (SP2) {
        PG8_STAGE(PG8_SB(0, 0), cB, voffB); PG8_STAGE(PG8_SB(0, 1), cB + hstep, voffB); PG8_STAGE(PG8_SA(0, 0), cA, voffA); PG8_STAGE(PG8_SA(0, 1), cA + hstep, voffA);
        if (wr == 1) PG8_BAR;
        PG8_WAIT_V(2); PG8_BAR;
        PG8_STAGE(PG8_SB(1, 0), cB + kstep, voffB); PG8_STAGE(PG8_SA(1, 0), cA + kstep, voffA); PG8_STAGE(PG8_SB(1, 1), cB + hstep + kstep, voffB);
        PG8_WAIT_V(6); PG8_BAR;
    } else {
        PG8_STAGE(PG8_SB(0, 0), cB, voffB); PG8_STAGE(PG8_SA(0, 0), cA, voffA); PG8_STAGE(PG8_SB(0, 1), cB + hstep, voffB); PG8_STAGE(PG8_SA(0, 1), cA + hstep, voffA);
        if (wr == 1) PG8_BAR;
        PG8_WAIT_V(4); PG8_BAR;
        PG8_STAGE(PG8_SB(1, 0), cB + kstep, voffB); PG8_STAGE(PG8_SA(1, 0), cA + kstep, voffA); PG8_STAGE(PG8_SB(1, 1), cB + hstep + kstep, voffB);
        PG8_WAIT_V(6); PG8_BAR;
    }
    for (;;) {
        const bool has_next = S.next(ui + 1, nxt);
        const char* nA = has_next ? (const char*)g.A + (size_t)nxt.pm * tstep + (size_t)nxt.k0 * kstep : cA; const char* nB = has_next ? (const char*)g.Bt + (size_t)nxt.pn * tstep + (size_t)nxt.k0 * kstep : cB;
        for (int t = 0; t < nt; t += 2) {
            const bool last = (t == nt - 2);
            const char* a1 = cA + (size_t)(t + 1) * kstep;
            const char* a2 = last ? nA : cA + (size_t)(t + 2) * kstep; const char* b2 = last ? nB : cB + (size_t)(t + 2) * kstep;
            const char* a3 = a2 + kstep; const char* b3 = b2 + kstep;
            if (last && has_next) S.a_ready(nxt);
            if constexpr (SP2) {
            PG8_LDB(B0, 0, 0); PG8_LDB(B1, 0, 1); PG8_SCHED; PG8_LDA(At, 0, 0); PG8_STAGE(PG8_SA(1, 1), a1 + hstep, voffA);
            PG8_WAIT_V(8); PG8_WAIT_L(0); PG8_BAR; PG8_MMA(0, 0, At, B0); PG8_MMA(0, 1, At, B1); PG8_BAR; PG8_SCHED;
            PG8_LDA(At, 0, 1); PG8_STAGE(PG8_SB(0, 0), b2, voffB); PG8_STAGE(PG8_SB(0, 1), b2 + hstep, voffB); PG8_STAGE(PG8_SA(0, 0), a2, voffA);
            PG8_WAIT_V(8); PG8_WAIT_L(0); PG8_BAR; PG8_MMA(1, 0, At, B0); PG8_MMA(1, 1, At, B1); PG8_BAR; PG8_SCHED;
            PG8_LDB(B0, 1, 0); PG8_LDB(B1, 1, 1); PG8_SCHED; PG8_LDA(At, 1, 0); PG8_STAGE(PG8_SA(0, 1), a2 + hstep, voffA);
            PG8_WAIT_V(8); PG8_WAIT_L(0); PG8_BAR; PG8_MMA(0, 0, At, B0); PG8_MMA(0, 1, At, B1); PG8_BAR; PG8_SCHED;
            PG8_LDA(At, 1, 1); PG8_STAGE(PG8_SB(1, 0), b3, voffB); PG8_STAGE(PG8_SB(1, 1), b3 + hstep, voffB); PG8_STAGE(PG8_SA(1, 0), a3, voffA);
            PG8_WAIT_V(8); PG8_WAIT_L(0); PG8_BAR; PG8_MMA(1, 0, At, B0); PG8_MMA(1, 1, At, B1); PG8_BAR; PG8_SCHED;
            } else {
            PG8_LDB(B0, 0, 0); PG8_SCHED; PG8_LDA(At, 0, 0); PG8_STAGE(PG8_SA(1, 1), a1 + hstep, voffA);
            PG8_WAIT_L(8); PG8_BAR; PG8_WAIT_L(0); PG8_MMA(0, 0, At, B0); PG8_BAR; PG8_SCHED;
            PG8_LDB(B1, 0, 1); PG8_STAGE(PG8_SB(0, 0), b2, voffB);
            PG8_BAR; PG8_WAIT_L(0); PG8_MMA(0, 1, At, B1); PG8_BAR;
            PG8_LDA(At, 0, 1); PG8_STAGE(PG8_SA(0, 0), a2, voffA);
            PG8_BAR; PG8_WAIT_L(0); PG8_MMA(1, 0, At, B0); PG8_BAR; PG8_SCHED;
            PG8_STAGE(PG8_SB(0, 1), b2 + hstep, voffB);
            PG8_WAIT_V(6); PG8_BAR; PG8_MMA(1, 1, At, B1); PG8_BAR;
            PG8_LDB(B0, 1, 0); PG8_SCHED; PG8_LDA(At, 1, 0); PG8_STAGE(PG8_SA(0, 1), a2 + hstep, voffA);
            PG8_WAIT_L(8); PG8_BAR; PG8_WAIT_L(0); PG8_MMA(0, 0, At, B0); PG8_BAR; PG8_SCHED;
            PG8_LDB(B1, 1, 1); PG8_STAGE(PG8_SB(1, 0), b3, voffB);
            PG8_BAR; PG8_WAIT_L(0); PG8_MMA(0, 1, At, B1); PG8_BAR;
            PG8_LDA(At, 1, 1); PG8_STAGE(PG8_SA(1, 0), a3, voffA);
            PG8_BAR; PG8_WAIT_L(0); PG8_MMA(1, 0, At, B0); PG8_BAR; PG8_SCHED;
            PG8_STAGE(PG8_SB(1, 1), b3 + hstep, voffB);
            PG8_WAIT_V(6); PG8_BAR; PG8_MMA(1, 1, At, B1); PG8_BAR;
            }
        }
        if constexpr (ALIGN_EPI) { if (wr == 0) PG8_BAR; }
        if constexpr (!Epi::AFTER_DRAIN) { E(acc, cur, wr, wc, fr, fq); S.done(cur); }
        if (!has_next) break;
#pragma unroll
        for (int a = 0; a < 2; ++a)
#pragma unroll
            for (int b = 0; b < 2; ++b)
#pragma unroll
                for (int m = 0; m < 4; ++m)
#pragma unroll
                    for (int n = 0; n < 2; ++n) acc[a][b][m][n] = (f32x4){0.f, 0.f, 0.f, 0.f};
        cur = nxt; cA = nA; cB = nB; ++ui; nt = cur.nt ? cur.nt : ntf;
        if constexpr (ALIGN_EPI) { if (wr == 1) PG8_BAR; }
    }
    PG8_WAIT_V(0);
    if constexpr (!ALIGN_EPI) { if (wr == 0) PG8_BAR; }
    PG8_BAR;
    if constexpr (Epi::AFTER_DRAIN) { E.fused(acc, cur, wr, wc, fr, fq, lds, wid, lane); S.done(cur); }
#undef PG8_SA
#undef PG8_SB
#undef PG8_STAGE
#undef PG8_LDA
#undef PG8_LDB
#undef PG8_MMA
#undef PG8_WAIT_V
#undef PG8_WAIT_L
#undef PG8_BAR
#undef PG8_SCHED
}
}
typedef unsigned short bfu;
typedef short s16x8 __attribute__((ext_vector_type(8)));
typedef float f4 __attribute__((ext_vector_type(4)));
typedef float f16v __attribute__((ext_vector_type(16)));
typedef unsigned u4 __attribute__((ext_vector_type(4)));
typedef unsigned u2 __attribute__((ext_vector_type(2)));
#define LAS3 __attribute__((address_space(3)))

constexpr int DM = 1024, MP = 32768, MS = 1024, MT = MP + MS, DFF = 2816, INC = 1792, NMODC = 9216, NCB = 144;
constexpr size_t MiB = 1u << 20;
constexpr size_t WS_CTL = 0, WS_MOD = 1 * MiB, WS_W = 12 * MiB, WS_H = 90 * MiB, WS_MG = 156 * MiB, WS_ACT = 222 * MiB, WS_END = 404 * MiB;
constexpr size_t W_UP1 = 0, W_DN1 = W_UP1 + (size_t)5632 * 1024, W_IN = W_DN1 + (size_t)1024 * 2816, W_OUT = W_IN + (size_t)1792 * 1024,
                 W_UP2 = W_OUT + (size_t)1024 * 1024, W_DN2 = W_UP2 + (size_t)5632 * 1024, W_LAYER = W_DN2 + (size_t)1024 * 2816;
static_assert(WS_W + 2 * W_LAYER * 2 <= WS_H, "weights fit");
constexpr size_t O_YP = 0, O_YS = 33554432, O_KP = 34603008, O_VP = O_KP + 524288, O_CP = O_VP + 524288, O_LP = O_CP + 49152, O_KS = O_LP + 16384,
                 O_VS = O_KS + 4194304, O_CS = O_VS + 4194304, O_LS = O_CS + 393216;
constexpr int LDS_BYTES = 131072 + 256;

typedef float f32x2_t __attribute__((ext_vector_type(2))); typedef __bf16 bf16x2_t __attribute__((ext_vector_type(2)));
__device__ __forceinline__ unsigned pkbf(float lo, float hi) { f32x2_t v = {lo, hi}; bf16x2_t b = __builtin_convertvector(v, bf16x2_t); return __builtin_bit_cast(unsigned, b); }
__device__ __forceinline__ float bflo(unsigned w) { return __uint_as_float(w << 16); }
__device__ __forceinline__ float bfhi(unsigned w) { return __uint_as_float(w & 0xffff0000u); }
__device__ __forceinline__ float bf1(bfu b) { return __uint_as_float(((unsigned)b) << 16); }
__device__ __forceinline__ bfu tobf(float f) { return (bfu)(pkbf(f, 0.f) & 0xffffu); }
__device__ __forceinline__ float sigm(float x) { return __builtin_amdgcn_rcpf(1.f + __expf(-x)); }
__device__ __forceinline__ float gelu_tanh(float x) { const float t = 0.7978845608028654f * (x + 0.044715f * x * x * x); return x * sigm(2.f * t); }
__device__ __forceinline__ int crow(int r, int hi) { return (r & 3) + 8 * (r >> 2) + 4 * hi; }

struct Params { const float* in[30]; float* out; unsigned char* ws; };

__device__ __forceinline__ int wq_next(unsigned* ctr, volatile int* slot) {
    __syncthreads();
    if (threadIdx.x == 0) *slot = (int)atomicAdd(ctr, 1u);
    __syncthreads();
    return *slot;
}

__device__ __forceinline__ void transpose_item(const float* W, int K, int N, bfu* WT, int mode, float* scr, int item, int lane) {
    const int nblk = N / 32, kb = item / nblk, nb = item % nblk, k0 = 64 * kb, n0 = 32 * nb;
    const int r0 = mode == 0 ? n0 : ((n0 >> 7) * 256 + (n0 & 127) + (mode == 2 ? 128 : 0));
    float wv[32];
#pragma unroll
    for (int i = 0; i < 32; ++i) { const int kk = 2 * i + (lane >> 5); wv[i] = __builtin_nontemporal_load(W + (size_t)(k0 + kk) * N + n0 + (lane & 31)); }
#pragma unroll
    for (int i = 0; i < 32; ++i) { const int kk = 2 * i + (lane >> 5); scr[kk * 33 + (lane & 31)] = wv[i]; }
    asm volatile("s_waitcnt lgkmcnt(0)" ::: "memory");
    const int c = lane & 7;
#pragma unroll
    for (int jj = 0; jj < 4; ++jj) { const int n = (lane >> 3) + 8 * jj; const float* s = scr + (8 * c) * 33 + n;
        u4 o; o.x = pkbf(s[0], s[33]); o.y = pkbf(s[66], s[99]); o.z = pkbf(s[132], s[165]); o.w = pkbf(s[198], s[231]);
        *(u4*)(WT + (size_t)(r0 + n) * K + k0 + 8 * c) = o; }
    asm volatile("s_waitcnt lgkmcnt(0)" ::: "memory");
}
constexpr int TI_BIG = 1408, TI_IN = 896, TI_OUT = 512, TI_ADA = 4608, TI_LAYER = 6 * TI_BIG + TI_IN + TI_OUT + TI_ADA;
constexpr int N_SC_ITEMS = 8, N_TR_WG_ITEMS = 2 * TI_LAYER / 8;
constexpr size_t WS_WADA = 404 * MiB, WS_SC = 440 * MiB;
__device__ __forceinline__ void prologue_phase(const Params& p, unsigned char* lds, unsigned* ctr, volatile int* slot) {
    int tid_ = threadIdx.x; asm volatile("" : "+v"(tid_));
    const int tid = tid_, lane = tid & 63, w = tid >> 6;
    bfu* wsW = (bfu*)(p.ws + WS_W); bfu* wada = (bfu*)(p.ws + WS_WADA); bfu* SC = (bfu*)(p.ws + WS_SC);
    for (;;) {
        const int it = wq_next(ctr, slot);
        if (it >= N_SC_ITEMS + N_TR_WG_ITEMS) break;
        if (it < N_SC_ITEMS) {
            const int row = it * 32 + (tid >> 4), c0 = (tid & 15) * 64;
            const float* src = row < 16 ? p.in[6] + (size_t)row * 1024 : (row < 144 ? p.in[7] + (size_t)(row - 16) * 1024 : nullptr);
#pragma unroll
            for (int e = 0; e < 16; ++e) { f4 c = src ? *(const f4*)(src + c0 + 4 * e) : (f4){0.f, 0.f, 0.f, 0.f};
                u2 o; o.x = pkbf(c.x * sigm(c.x), c.y * sigm(c.y)); o.y = pkbf(c.z * sigm(c.z), c.w * sigm(c.w));
                *(u2*)(SC + (size_t)row * 1024 + c0 + 4 * e) = o; }
            continue; }
        int wi = (it - N_SC_ITEMS) * 8 + w; const int l = wi / TI_LAYER; int r = wi % TI_LAYER;
        bfu* wl = wsW + (size_t)l * W_LAYER; float* scr = (float*)lds + w * (64 * 33);
        if (r < TI_ADA) { transpose_item(p.in[8] + (size_t)l * 1024 * NMODC, 1024, NMODC, wada + (size_t)l * NMODC * 1024, 0, scr, r, lane); continue; } r -= TI_ADA;
        if (r < TI_BIG) { transpose_item(p.in[10] + (size_t)l * 1024 * DFF, 1024, DFF, wl + W_UP1, 1, scr, r, lane); continue; } r -= TI_BIG;
        if (r < TI_BIG) { transpose_item(p.in[11] + (size_t)l * 1024 * DFF, 1024, DFF, wl + W_UP1, 2, scr, r, lane); continue; } r -= TI_BIG;
        if (r < TI_BIG) { transpose_item(p.in[12] + (size_t)l * DFF * 1024, DFF, 1024, wl + W_DN1, 0, scr, r, lane); continue; } r -= TI_BIG;
        if (r < TI_IN) { transpose_item(p.in[13] + (size_t)l * 1024 * INC, 1024, INC, wl + W_IN, 0, scr, r, lane); continue; } r -= TI_IN;
        if (r < TI_OUT) { transpose_item(p.in[26] + (size_t)l * 1024 * 1024, 1024, 1024, wl + W_OUT, 0, scr, r, lane); continue; } r -= TI_OUT;
        if (r < TI_BIG) { transpose_item(p.in[27] + (size_t)l * 1024 * DFF, 1024, DFF, wl + W_UP2, 1, scr, r, lane); continue; } r -= TI_BIG;
        if (r < TI_BIG) { transpose_item(p.in[28] + (size_t)l * 1024 * DFF, 1024, DFF, wl + W_UP2, 2, scr, r, lane); continue; } r -= TI_BIG;
        transpose_item(p.in[29] + (size_t)l * DFF * 1024, DFF, 1024, wl + W_DN2, 0, scr, r, lane);
    }
}

__device__ __forceinline__ float wave_sum(float v) {
#pragma unroll
    for (int o = 1; o < 64; o <<= 1) v += __shfl_xor(v, o);
    return v;
}
__device__ __forceinline__ void norm_phase(const float* xP, const float* xS, const float* modl, int shi, int sci, bfu* H, const float* part, int nch, float* XSout, const bfu* XbP) {
    int tid_ = threadIdx.x; asm volatile("" : "+v"(tid_));
    const int lane = tid_ & 63, gw = blockIdx.x * 8 + (tid_ >> 6), NGW = gridDim.x * 8;
    f4 v[4], sh[4], sc[4];
    auto ld = [&](int row, f4 (&vv)[4], f4 (&shh)[4], f4 (&scc)[4]) {
        const bool pr = row < MP;
        const f4* xr = (const f4*)(pr ? xP + (size_t)row * DM : xS + (size_t)(row - MP) * DM) + lane;
        const int cb = pr ? (row >> 11) : 16 + ((row - MP) >> 3);
        const f4* shp = (const f4*)(modl + (size_t)cb * NMODC + shi * DM) + lane; const f4* scp = (const f4*)(modl + (size_t)cb * NMODC + sci * DM) + lane;
#pragma unroll
        for (int j = 0; j < 4; ++j) { shh[j] = shp[64 * j]; scc[j] = scp[64 * j]; }
        if (XbP != nullptr && pr) {
            const u2* hr = (const u2*)(XbP + (size_t)row * DM) + lane;
#pragma unroll
            for (int j = 0; j < 4; ++j) { const u2 w = __builtin_nontemporal_load(hr + 64 * j); vv[j] = (f4){bflo(w.x), bfhi(w.x), bflo(w.y), bfhi(w.y)}; }
        } else {
#pragma unroll
            for (int j = 0; j < 4; ++j) vv[j] = __builtin_nontemporal_load(xr + 64 * j);
        }
    };
    if (gw < MT) ld(gw, v, sh, sc);
    for (int row = gw; row < MT; row += NGW) {
        f4 vn[4], shn[4], scn[4];
        const int nrow = row + NGW;
        if (nrow < MT) ld(nrow, vn, shn, scn);
        if (nch > 0 && row >= MP) {
            const f4* pp = (const f4*)(part + (size_t)(row - MP) * DM) + lane;
            for (int ch = 0; ch < nch; ch += 4) {
                f4 t[4][4];
#pragma unroll
                for (int c2 = 0; c2 < 4; ++c2)
#pragma unroll
                    for (int j = 0; j < 4; ++j) t[c2][j] = (ch + c2 < nch) ? pp[(size_t)(ch + c2) * (1024 * 1024 / 4) + 64 * j] : (f4){0.f, 0.f, 0.f, 0.f};
#pragma unroll
                for (int c2 = 0; c2 < 4; ++c2)
#pragma unroll
                    for (int j = 0; j < 4; ++j) v[j] += t[c2][j];
            }
            f4* xo = (f4*)(XSout + (size_t)(row - MP) * DM) + lane;
#pragma unroll
            for (int j = 0; j < 4; ++j) xo[64 * j] = v[j];
        }
        float s = 0.f;
#pragma unroll
        for (int j = 0; j < 4; ++j) s += (v[j].x * v[j].x + v[j].y * v[j].y) + (v[j].z * v[j].z + v[j].w * v[j].w);
        const float rstd = rsqrtf(wave_sum(s) * (1.f / DM) + 1e-6f);
        u2* o8 = (u2*)(H + (size_t)row * DM) + lane;
#pragma unroll
        for (int j = 0; j < 4; ++j) { const f4 y = v[j] * rstd * (sc[j] + 1.f) + sh[j];
            u2 o; o.x = pkbf(y.x, y.y); o.y = pkbf(y.z, y.w); o8[64 * j] = o; }
#pragma unroll
        for (int j = 0; j < 4; ++j) { v[j] = vn[j]; sh[j] = shn[j]; sc[j] = scn[j]; }
    }
}
__device__ __forceinline__ void mgnorm_phase(const bfu* MG, bfu* OUT, const float* betaA, const float* betaL) {
    int tid_ = threadIdx.x; asm volatile("" : "+v"(tid_));
    const int lane = tid_ & 63, gw = blockIdx.x * 8 + (tid_ >> 6), NGW = gridDim.x * 8;
    const float* bp = lane < 32 ? betaA + lane * 16 : betaL + (lane - 32) * 16;
    float be[16];
#pragma unroll
    for (int e = 0; e < 4; ++e) { const f4 b = ((const f4*)bp)[e]; be[4 * e] = b.x; be[4 * e + 1] = b.y; be[4 * e + 2] = b.z; be[4 * e + 3] = b.w; }
    for (int row0 = gw; row0 < MT; row0 += 4 * NGW) {
        u4 ra[4], rb[4];
#pragma unroll
        for (int i = 0; i < 4; ++i) { const int row = row0 + i * NGW; if (row < MT) { const u4* rp = (const u4*)(MG + (size_t)row * DM + lane * 16); ra[i] = rp[0]; rb[i] = rp[1]; } }
#pragma unroll
        for (int i = 0; i < 4; ++i) { const int row = row0 + i * NGW; if (row < MT) {
            const unsigned wv[8] = {ra[i].x, ra[i].y, ra[i].z, ra[i].w, rb[i].x, rb[i].y, rb[i].z, rb[i].w};
            float f[16]; float s = 0.f;
#pragma unroll
            for (int e = 0; e < 8; ++e) { f[2 * e] = bflo(wv[e]); f[2 * e + 1] = bfhi(wv[e]); s += f[2 * e] * f[2 * e] + f[2 * e + 1] * f[2 * e + 1]; }
#pragma unroll
            for (int o = 1; o < 32; o <<= 1) s += __shfl_xor(s, o);
            const float rstd = rsqrtf(s * (1.f / 512.f) + 1e-6f);
            u4 oa, ob;
            oa.x = pkbf(f[0] * rstd * be[0], f[1] * rstd * be[1]); oa.y = pkbf(f[2] * rstd * be[2], f[3] * rstd * be[3]);
            oa.z = pkbf(f[4] * rstd * be[4], f[5] * rstd * be[5]); oa.w = pkbf(f[6] * rstd * be[6], f[7] * rstd * be[7]);
            ob.x = pkbf(f[8] * rstd * be[8], f[9] * rstd * be[9]); ob.y = pkbf(f[10] * rstd * be[10], f[11] * rstd * be[11]);
            ob.z = pkbf(f[12] * rstd * be[12], f[13] * rstd * be[13]); ob.w = pkbf(f[14] * rstd * be[14], f[15] * rstd * be[15]);
            u4* wp = (u4*)(OUT + (size_t)row * DM + lane * 16); wp[0] = oa; wp[1] = ob; } }
    }
}
__device__ __forceinline__ void fix_phase(float* XS, const float* part, int nch) {
    int tid_ = threadIdx.x; asm volatile("" : "+v"(tid_));
    const int lane = tid_ & 63, gw = blockIdx.x * 8 + (tid_ >> 6), NGW = gridDim.x * 8;
    for (int row = gw; row < MS; row += NGW) {
        f4* xr = (f4*)(XS + (size_t)row * DM) + lane; const f4* pp = (const f4*)(part + (size_t)row * DM) + lane;
        f4 v[4];
#pragma unroll
        for (int j = 0; j < 4; ++j) v[j] = xr[64 * j];
        for (int ch = 0; ch < nch; ch += 4) {
            f4 t[4][4];
#pragma unroll
            for (int c2 = 0; c2 < 4; ++c2)
#pragma unroll
                for (int j = 0; j < 4; ++j) t[c2][j] = (ch + c2 < nch) ? pp[(size_t)(ch + c2) * (1024 * 1024 / 4) + 64 * j] : (f4){0.f, 0.f, 0.f, 0.f};
#pragma unroll
            for (int c2 = 0; c2 < 4; ++c2)
#pragma unroll
                for (int j = 0; j < 4; ++j) v[j] += t[c2][j];
        }
#pragma unroll
        for (int j = 0; j < 4; ++j) xr[64 * j] = v[j];
    }
}
__device__ __forceinline__ void attn_item(int idx, const bfu* Z, const float* qg, const float* kg, const float* sinks, bfu* MG, float* outk, float* outv, unsigned char* lds) {
    int tid_ = threadIdx.x; asm volatile("" : "+v"(tid_));
    const int tid = tid_, lane = tid & 63, wave = __builtin_amdgcn_readfirstlane(tid >> 6);
    const int b = idx >> 5, nb = (idx >> 1) & 15, kvh = idx & 1, R0 = b * 2048 + nb * 128;
    bfu* Ks = (bfu*)lds;
    bfu* Vt = (bfu*)(lds + 36864);
#ifdef DBG_ZERO_LDS
    for (int i = tid; i < 70656 / 16; i += 512) ((u4*)lds)[i] = (u4){0u, 0u, 0u, 0u};
    __syncthreads();
#endif
    {
        const int kr = tid >> 1, half = tid & 1;
        const bool ok = (nb > 0) || (kr >= 128);
        u4 kw[4], vw[4];
        if (ok) { const u4* kp = (const u4*)(Z + (size_t)(R0 - 128 + kr) * INC + 512 + kvh * 64 + half * 32); const u4* vp = (const u4*)(Z + (size_t)(R0 - 128 + kr) * INC + 640 + kvh * 64 + half * 32);
#pragma unroll
            for (int e = 0; e < 4; ++e) { kw[e] = kp[e]; vw[e] = vp[e]; } }
        else {
#pragma unroll
            for (int e = 0; e < 4; ++e) { kw[e] = (u4){0u, 0u, 0u, 0u}; vw[e] = (u4){0u, 0u, 0u, 0u}; } }
        float kf[32]; float ss = 0.f;
#pragma unroll
        for (int e = 0; e < 4; ++e) { const unsigned ww[4] = {kw[e].x, kw[e].y, kw[e].z, kw[e].w};
#pragma unroll
            for (int t = 0; t < 4; ++t) { kf[8 * e + 2 * t] = bflo(ww[t]); kf[8 * e + 2 * t + 1] = bfhi(ww[t]); } }
#pragma unroll
        for (int e = 0; e < 32; ++e) ss += kf[e] * kf[e];
        ss += __shfl_xor(ss, 1);
        const float rs = rsqrtf(ss * (1.f / 64.f) + 1e-6f);
#pragma unroll
        for (int e = 0; e < 32; ++e) kf[e] = kf[e] * rs * kg[half * 32 + e];
        u4* kd = (u4*)(Ks + kr * 72 + half * 32);
#pragma unroll
        for (int e = 0; e < 4; ++e) { u4 o; o.x = pkbf(kf[8 * e], kf[8 * e + 1]); o.y = pkbf(kf[8 * e + 2], kf[8 * e + 3]); o.z = pkbf(kf[8 * e + 4], kf[8 * e + 5]); o.w = pkbf(kf[8 * e + 6], kf[8 * e + 7]); kd[e] = o; }
#pragma unroll
        for (int e = 0; e < 4; ++e) { const unsigned ww[4] = {vw[e].x, vw[e].y, vw[e].z, vw[e].w};
#pragma unroll
            for (int t = 0; t < 4; ++t) { Vt[(half * 32 + 8 * e + 2 * t) * 264 + kr] = (bfu)(ww[t] & 0xffffu); Vt[(half * 32 + 8 * e + 2 * t + 1) * 264 + kr] = (bfu)(ww[t] >> 16); } }
        if (nb == 15 && kr >= 128) {
            float* ko = outk + ((size_t)(b * 128 + kr - 128) * 2 + kvh) * 64 + half * 32; float* vo = outv + ((size_t)(b * 128 + kr - 128) * 2 + kvh) * 64 + half * 32;
#pragma unroll
            for (int e = 0; e < 8; ++e) ((f4*)ko)[e] = (f4){kf[4 * e], kf[4 * e + 1], kf[4 * e + 2], kf[4 * e + 3]};
#pragma unroll
            for (int e = 0; e < 4; ++e) { const unsigned ww[4] = {vw[e].x, vw[e].y, vw[e].z, vw[e].w};
                ((f4*)vo)[2 * e] = (f4){bflo(ww[0]), bfhi(ww[0]), bflo(ww[1]), bfhi(ww[1])}; ((f4*)vo)[2 * e + 1] = (f4){bflo(ww[2]), bfhi(ww[2]), bflo(ww[3]), bfhi(ww[3])}; }
        }
    }
    __syncthreads();
    const int q = lane & 31, hi = lane >> 5;
#pragma unroll 1
    for (int itk = 0; itk < 2; ++itk) {
        const int task = wave + 8 * itk, g = task & 3, qs = task >> 2, h = kvh * 4 + g;
        int qq = q; asm volatile("" : "+v"(qq));
        const bfu* qp = Z + (size_t)(R0 + 32 * qs + q) * INC + h * 64 + hi * 8;
        float qv[32]; float ss = 0.f;
#pragma unroll
        for (int ds = 0; ds < 4; ++ds) { const u4 raw = *(const u4*)(qp + 16 * ds); const unsigned ww[4] = {raw.x, raw.y, raw.z, raw.w};
#pragma unroll
            for (int t = 0; t < 4; ++t) { qv[8 * ds + 2 * t] = bflo(ww[t]); qv[8 * ds + 2 * t + 1] = bfhi(ww[t]); } }
#pragma unroll
        for (int e = 0; e < 32; ++e) ss += qv[e] * qv[e];
        ss += __shfl_xor(ss, 32);
        const float qsc = rsqrtf(ss * (1.f / 64.f) + 1e-6f) * 0.125f;
        s16x8 qf[4];
#pragma unroll
        for (int ds = 0; ds < 4; ++ds) { const float* gp = qg + 16 * ds + 8 * hi; u4 o;
            o.x = pkbf(qv[8 * ds] * qsc * gp[0], qv[8 * ds + 1] * qsc * gp[1]); o.y = pkbf(qv[8 * ds + 2] * qsc * gp[2], qv[8 * ds + 3] * qsc * gp[3]);
            o.z = pkbf(qv[8 * ds + 4] * qsc * gp[4], qv[8 * ds + 5] * qsc * gp[5]); o.w = pkbf(qv[8 * ds + 6] * qsc * gp[6], qv[8 * ds + 7] * qsc * gp[7]);
            qf[ds] = __builtin_bit_cast(s16x8, o); }
        const float slope = exp2f(-(float)(h + 1)), sink = sinks[h];
        const int jt0 = (nb == 0) ? 4 : qs;
        f16v S[5];
        float m = sink;
#pragma unroll
        for (int x = 0; x < 5; ++x) {
            const int jt = qs + x;
            if (jt >= jt0) {
                f16v acc;
#pragma unroll
                for (int r = 0; r < 16; ++r) acc[r] = 0.f;
#pragma unroll
                for (int ds = 0; ds < 4; ++ds) { const s16x8 a = *(const s16x8*)(Ks + (32 * jt + q) * 72 + 16 * ds + 8 * hi); acc = __builtin_amdgcn_mfma_f32_32x32x16_bf16(a, qf[ds], acc, 0, 0, 0); }
#pragma unroll
                for (int r = 0; r < 16; ++r) { const int dist = 128 + 32 * qs + qq - (32 * jt + crow(r, hi)); const bool valid = dist >= 0 && dist <= 128;
                    const float sv = valid ? acc[r] - slope * (float)dist : -1e30f; S[x][r] = sv; m = fmaxf(m, sv); }
            } else {
#pragma unroll
                for (int r = 0; r < 16; ++r) S[x][r] = -1e30f;
            }
        }
        m = fmaxf(m, __shfl_xor(m, 32));
        float l = 0.f;
#pragma unroll
        for (int x = 0; x < 5; ++x)
#pragma unroll
            for (int r = 0; r < 16; ++r) { const float pe = __expf(S[x][r] - m); S[x][r] = pe; l += pe; }
        l += __shfl_xor(l, 32);
        l += __expf(sink - m);
        const float rinv = 1.f / l;
        f16v o0, o1;
#pragma unroll
        for (int r = 0; r < 16; ++r) { o0[r] = 0.f; o1[r] = 0.f; }
#pragma unroll
        for (int x = 0; x < 5; ++x) {
            const int jt = qs + x;
            if (jt >= jt0) {
#pragma unroll
                for (int s2 = 0; s2 < 2; ++s2) {
                    u4 pa; pa.x = pkbf(S[x][8 * s2], S[x][8 * s2 + 1]); pa.y = pkbf(S[x][8 * s2 + 2], S[x][8 * s2 + 3]); pa.z = pkbf(S[x][8 * s2 + 4], S[x][8 * s2 + 5]); pa.w = pkbf(S[x][8 * s2 + 6], S[x][8 * s2 + 7]);
                    const s16x8 A = __builtin_bit_cast(s16x8, pa);
                    const bfu* vp0 = Vt + q * 264 + 32 * jt + 16 * s2 + 4 * hi; const bfu* vp1 = vp0 + 32 * 264;
                    const u2 a0 = *(const u2*)vp0, a1 = *(const u2*)(vp0 + 8), b0 = *(const u2*)vp1, b1 = *(const u2*)(vp1 + 8);
                    const u4 B0 = {a0.x, a0.y, a1.x, a1.y}, B1 = {b0.x, b0.y, b1.x, b1.y};
                    o0 = __builtin_amdgcn_mfma_f32_32x32x16_bf16(A, __builtin_bit_cast(s16x8, B0), o0, 0, 0, 0);
                    o1 = __builtin_amdgcn_mfma_f32_32x32x16_bf16(A, __builtin_bit_cast(s16x8, B1), o1, 0, 0, 0);
                }
            }
        }
        bfu* op = MG + (size_t)(R0 + 32 * qs) * DM + h * 64 + q;
#pragma unroll
        for (int r = 0; r < 16; ++r) { const int qr = crow(r, hi); const float rl = __shfl(rinv, qr);
            op[(size_t)qr * DM] = tobf(o0[r] * rl); op[(size_t)qr * DM + 32] = tobf(o1[r] * rl); }
    }
}

__device__ __forceinline__ void sattn_item(int b, const bfu* Z, const float* ck, const float* cv, const float* qg, const float* kg, const float* sinks, bfu* MG, float* outk, float* outv, unsigned char* lds) {
    int tid_ = threadIdx.x; asm volatile("" : "+v"(tid_));
    const int tid = tid_, lane = tid & 63, wave = __builtin_amdgcn_readfirstlane(tid >> 6);
    bfu* KK = (bfu*)lds;
    bfu* VV = (bfu*)(lds + 34816);
    float* QS = (float*)(lds + 69632);
    float* SC = (float*)(lds + 86016);
    const float* ckb = ck + (size_t)b * 16384; const float* cvb = cv + (size_t)b * 16384;
    float* okb = outk + (size_t)b * 16384; float* ovb = outv + (size_t)b * 16384;
#pragma unroll
    for (int it = 0; it < 8; ++it) { const int i = tid + 512 * it, row = i >> 5, c4 = (i & 31) * 4;
        const f4 k4 = ((const f4*)ckb)[i], v4 = ((const f4*)cvb)[i];
        u2 o; o.x = pkbf(k4.x, k4.y); o.y = pkbf(k4.z, k4.w); *(u2*)(KK + row * 128 + c4) = o;
        o.x = pkbf(v4.x, v4.y); o.y = pkbf(v4.z, v4.w); *(u2*)(VV + row * 128 + c4) = o;
        if (row >= 8) { ((f4*)okb)[i - 256] = k4; ((f4*)ovb)[i - 256] = v4; } }
    {
        const int pair = tid >> 5, i = pair >> 1, kvh = pair & 1, dd = (tid & 31) * 2;
        const bfu* zr = Z + (size_t)(MP + 8 * b + i) * INC;
        const unsigned kwd = *(const unsigned*)(zr + 512 + kvh * 64 + dd), vwd = *(const unsigned*)(zr + 640 + kvh * 64 + dd);
        float k0 = bflo(kwd), k1 = bfhi(kwd); float ss = k0 * k0 + k1 * k1;
#pragma unroll
        for (int o = 1; o < 32; o <<= 1) ss += __shfl_xor(ss, o);
        const float rs = rsqrtf(ss * (1.f / 64.f) + 1e-6f);
        k0 = k0 * rs * kg[dd]; k1 = k1 * rs * kg[dd + 1];
        *(unsigned*)(KK + (128 + i) * 128 + kvh * 64 + dd) = pkbf(k0, k1); *(unsigned*)(VV + (128 + i) * 128 + kvh * 64 + dd) = vwd;
        float* ko = okb + (size_t)(120 + i) * 128 + kvh * 64 + dd; ko[0] = k0; ko[1] = k1;
        float* vo = ovb + (size_t)(120 + i) * 128 + kvh * 64 + dd; vo[0] = bflo(vwd); vo[1] = bfhi(vwd);
    }
    {
        const int pair = tid >> 3, i = pair >> 3, h = pair & 7, d0 = (tid & 7) * 8;
        const u4 raw = *(const u4*)(Z + (size_t)(MP + 8 * b + i) * INC + h * 64 + d0); const unsigned ww[4] = {raw.x, raw.y, raw.z, raw.w};
        float qv[8]; float ss = 0.f;
#pragma unroll
        for (int t = 0; t < 4; ++t) { qv[2 * t] = bflo(ww[t]); qv[2 * t + 1] = bfhi(ww[t]); ss += qv[2 * t] * qv[2 * t] + qv[2 * t + 1] * qv[2 * t + 1]; }
        ss += __shfl_xor(ss, 1); ss += __shfl_xor(ss, 2); ss += __shfl_xor(ss, 4);
        const float rs = rsqrtf(ss * (1.f / 64.f) + 1e-6f) * 0.125f;
#pragma unroll
        for (int e = 0; e < 8; ++e) QS[i * 512 + h * 64 + d0 + e] = qv[e] * rs * qg[d0 + e];
    }
    __syncthreads();
    {
        const int i = lane >> 3, h = lane & 7, kvh = h >> 2;
        float qr[64];
#pragma unroll
        for (int e = 0; e < 16; ++e) { const f4 t = *(const f4*)&QS[i * 512 + h * 64 + 4 * e]; qr[4 * e] = t.x; qr[4 * e + 1] = t.y; qr[4 * e + 2] = t.z; qr[4 * e + 3] = t.w; }
        const float slope = exp2f(-(float)(h + 1));
        for (int j = wave; j < 136; j += 8) {
            const u4* kp = (const u4*)(KK + j * 128 + kvh * 64); float d = 0.f;
#pragma unroll
            for (int c = 0; c < 8; ++c) { const u4 kw = kp[c]; const unsigned ww[4] = {kw.x, kw.y, kw.z, kw.w};
#pragma unroll
                for (int t = 0; t < 4; ++t) d += qr[8 * c + 2 * t] * bflo(ww[t]) + qr[8 * c + 2 * t + 1] * bfhi(ww[t]); }
            const int dist = 128 + i - j; const bool valid = dist >= 0 && dist <= 128;
            SC[lane * 137 + j] = valid ? d - slope * (float)dist : -1e30f;
        }
    }
    __syncthreads();
    {
        const int pair = tid >> 3, sub = tid & 7, h = pair & 7; const float sink = sinks[h];
        float m = sink;
        for (int j = sub; j < 136; j += 8) m = fmaxf(m, SC[pair * 137 + j]);
        m = fmaxf(m, __shfl_xor(m, 1)); m = fmaxf(m, __shfl_xor(m, 2)); m = fmaxf(m, __shfl_xor(m, 4));
        float l = 0.f;
        for (int j = sub; j < 136; j += 8) { const float pe = __expf(SC[pair * 137 + j] - m); SC[pair * 137 + j] = pe; l += pe; }
        l += __shfl_xor(l, 1); l += __shfl_xor(l, 2); l += __shfl_xor(l, 4);
        l += __expf(sink - m);
        const float rl = 1.f / l;
        for (int j = sub; j < 136; j += 8) SC[pair * 137 + j] *= rl;
    }
    __syncthreads();
    {
        const int pair = tid >> 3, dc = tid & 7, i = pair >> 3, h = pair & 7, kvh = h >> 2;
        float acc[8];
#pragma unroll
        for (int e = 0; e < 8; ++e) acc[e] = 0.f;
        for (int j = 0; j < 136; ++j) { const float pj = SC[pair * 137 + j]; const u4 vw = *(const u4*)(VV + j * 128 + kvh * 64 + dc * 8); const unsigned ww[4] = {vw.x, vw.y, vw.z, vw.w};
#pragma unroll
            for (int t = 0; t < 4; ++t) { acc[2 * t] += pj * bflo(ww[t]); acc[2 * t + 1] += pj * bfhi(ww[t]); } }
        u4 o; o.x = pkbf(acc[0], acc[1]); o.y = pkbf(acc[2], acc[3]); o.z = pkbf(acc[4], acc[5]); o.w = pkbf(acc[6], acc[7]);
        *(u4*)(MG + (size_t)(MP + 8 * b + i) * DM + h * 64 + dc * 8) = o;
    }
}
template <bool SAMPLE>
__device__ __forceinline__ void lru_item(int idx, const bfu* Z, const float* st_conv, const float* st_lru, const float* convw, const float* convb, const float* wrg, const float* brg,
                                         const float* wig, const float* big, const float* lam, bfu* MG, float* out_conv, float* out_lru, unsigned char* lds) {
    constexpr int L = SAMPLE ? 8 : 64, NT = SAMPLE ? 1 : 32, XROWS = SAMPLE ? 88 : 67;
    int tid_ = threadIdx.x; asm volatile("" : "+v"(tid_));
    const int tid = tid_, lane = tid & 63, wave = __builtin_amdgcn_readfirstlane(tid >> 6);
    const int n = idx & 7, bb = idx >> 3;
    const int rowbase = SAMPLE ? MP + bb * 64 : bb * 2048, ch0 = n * 64;
    float* XRS = (float*)lds;
    bfu* XCB = (bfu*)(lds + 22528);
    float* XCF = (float*)(lds + 31744);
    bfu* WRT = (bfu*)(lds + 48128);
    bfu* WIT = (bfu*)(lds + 57344);
    float* AA = (float*)(lds + 66560);
    float* UU = (float*)(lds + 82944);
    bfu* GR = (bfu*)(lds + 99328);
    float* COMB = (float*)(lds + 107520);
    float* HCAR = (float*)(lds + 111616);
    {
        const int c = tid >> 3, d0 = (tid & 7) * 8;
        const f4* rp = (const f4*)(wrg + (size_t)n * 4096 + c * 64 + d0); const f4* ip = (const f4*)(wig + (size_t)n * 4096 + c * 64 + d0);
        const f4 r0 = rp[0], r1 = rp[1], i0 = ip[0], i1 = ip[1];
        const float rv[8] = {r0.x, r0.y, r0.z, r0.w, r1.x, r1.y, r1.z, r1.w}, iv[8] = {i0.x, i0.y, i0.z, i0.w, i1.x, i1.y, i1.z, i1.w};
#pragma unroll
        for (int e = 0; e < 8; ++e) { WRT[(d0 + e) * 72 + c] = tobf(rv[e]); WIT[(d0 + e) * 72 + c] = tobf(iv[e]); }
        if (tid < 64) HCAR[tid] = 0.f;
    }
    const int ct_t = tid >> 3, ct_c = (tid & 7) * 8;
    float cw[4][8], cbv[8];
#pragma unroll
    for (int e = 0; e < 8; ++e) { cbv[e] = convb[ch0 + ct_c + e];
#pragma unroll
        for (int tap = 0; tap < 4; ++tap) cw[tap][e] = convw[tap * 512 + ch0 + ct_c + e]; }
    const int fr = lane & 15, fq = lane >> 4, rt = wave >> 1;
    float g_br[2], g_bi[2], g_sp[2];
#pragma unroll
    for (int cc = 0; cc < 2; ++cc) { const int d = 16 * (2 * (wave & 1) + cc) + fr; g_br[cc] = brg[ch0 + d]; g_bi[cc] = big[ch0 + d];
        const float x = -lam[ch0 + d]; g_sp[cc] = fmaxf(x, 0.f) + log1pf(__expf(-fabsf(x))); }
    u4 pxr[2], pgr; f4 pst[2][2];
    auto prefetch = [&](int tt) {
        const int t0 = tt * 64;
#pragma unroll
        for (int k = 0; k < 2; ++k) { const int i = tid + 512 * k; pxr[k] = (u4){0u, 0u, 0u, 0u};
            if (i < XROWS * 8) { const int xrow = i >> 3, cc = (i & 7) * 8;
                if (SAMPLE) { const int seg = xrow / 11, rr = xrow % 11;
                    if (rr < 3) { const f4* sp = (const f4*)(st_conv + ((size_t)(bb * 8 + seg) * 3 + rr) * 512 + ch0 + cc); pst[k][0] = sp[0]; pst[k][1] = sp[1]; }
                    else pxr[k] = *(const u4*)(Z + (size_t)(rowbase + seg * 8 + rr - 3) * INC + 768 + ch0 + cc); }
                else { const int trel = t0 - 3 + xrow; if (trel >= 0) pxr[k] = *(const u4*)(Z + (size_t)(rowbase + trel) * INC + 768 + ch0 + cc); } } }
        pgr = *(const u4*)(Z + (size_t)(rowbase + t0 + (tid >> 3)) * INC + 1280 + ch0 + (tid & 7) * 8);
    };
    prefetch(0);
    for (int tt = 0; tt < NT; ++tt) {
        const int t0 = tt * 64;
#pragma unroll
        for (int k = 0; k < 2; ++k) { const int i = tid + 512 * k;
            if (i < XROWS * 8) { const int xrow = i >> 3, cc = (i & 7) * 8; f4 lo, hi4;
                if (SAMPLE && (xrow % 11) < 3) { lo = pst[k][0]; hi4 = pst[k][1]; }
                else { lo = (f4){bflo(pxr[k].x), bfhi(pxr[k].x), bflo(pxr[k].y), bfhi(pxr[k].y)}; hi4 = (f4){bflo(pxr[k].z), bfhi(pxr[k].z), bflo(pxr[k].w), bfhi(pxr[k].w)}; }
                *(f4*)&XRS[xrow * 64 + cc] = lo; *(f4*)&XRS[xrow * 64 + cc + 4] = hi4; } }
        *(u4*)(GR + (tid >> 3) * 64 + (tid & 7) * 8) = pgr;
        __syncthreads();
        if (tt + 1 < NT) prefetch(tt + 1);
        if (SAMPLE) {
#pragma unroll
            for (int k = 0; k < 3; ++k) { const int i = tid + 512 * k, seg = i / 192, rr = (i % 192) >> 6, c = i & 63;
                out_conv[((size_t)(bb * 8 + seg) * 3 + rr) * 512 + ch0 + c] = XRS[(seg * 11 + 8 + rr) * 64 + c]; }
        } else if (tt == NT - 1) {
            if (tid < 192) { const int rr = tid >> 6, c = tid & 63; out_conv[((size_t)bb * 3 + rr) * 512 + ch0 + c] = XRS[(64 + rr) * 64 + c]; }
        }
        {
            const int seg = ct_t / L, tl = ct_t % L, xr0 = seg * (L + 3) + tl;
            float v[8];
#pragma unroll
            for (int e = 0; e < 8; ++e) v[e] = cbv[e];
#pragma unroll
            for (int tap = 0; tap < 4; ++tap) { const f4 a = *(const f4*)&XRS[(xr0 + tap) * 64 + ct_c], b4 = *(const f4*)&XRS[(xr0 + tap) * 64 + ct_c + 4];
                v[0] += cw[tap][0] * a.x; v[1] += cw[tap][1] * a.y; v[2] += cw[tap][2] * a.z; v[3] += cw[tap][3] * a.w;
                v[4] += cw[tap][4] * b4.x; v[5] += cw[tap][5] * b4.y; v[6] += cw[tap][6] * b4.z; v[7] += cw[tap][7] * b4.w; }
            *(f4*)&XCF[ct_t * 64 + ct_c] = (f4){v[0], v[1], v[2], v[3]}; *(f4*)&XCF[ct_t * 64 + ct_c + 4] = (f4){v[4], v[5], v[6], v[7]};
            u4 o; o.x = pkbf(v[0], v[1]); o.y = pkbf(v[2], v[3]); o.z = pkbf(v[4], v[5]); o.w = pkbf(v[6], v[7]);
            *(u4*)(XCB + ct_t * 72 + ct_c) = o;
        }
        __syncthreads();
        {
            const s16x8 a0 = *(const s16x8*)(XCB + (16 * rt + fr) * 72 + 8 * fq), a1 = *(const s16x8*)(XCB + (16 * rt + fr) * 72 + 32 + 8 * fq);
#pragma unroll
            for (int cc = 0; cc < 2; ++cc) { const int ct = 2 * (wave & 1) + cc;
                const bfu* wr_ = WRT + (16 * ct + fr) * 72 + 8 * fq; const bfu* wi_ = WIT + (16 * ct + fr) * 72 + 8 * fq;
                f4 ar = {0.f, 0.f, 0.f, 0.f}, ai = {0.f, 0.f, 0.f, 0.f};
                ar = __builtin_amdgcn_mfma_f32_16x16x32_bf16(a0, *(const s16x8*)wr_, ar, 0, 0, 0); ar = __builtin_amdgcn_mfma_f32_16x16x32_bf16(a1, *(const s16x8*)(wr_ + 32), ar, 0, 0, 0);
                ai = __builtin_amdgcn_mfma_f32_16x16x32_bf16(a0, *(const s16x8*)wi_, ai, 0, 0, 0); ai = __builtin_amdgcn_mfma_f32_16x16x32_bf16(a1, *(const s16x8*)(wi_ + 32), ai, 0, 0, 0);
                const int d = 16 * ct + fr;
#pragma unroll
                for (int e = 0; e < 4; ++e) { const int t = 16 * rt + 4 * fq + e; const float xc = XCF[t * 64 + d];
                    const float r = sigm(ar[e] + g_br[cc]), gi = sigm(ai[e] + g_bi[cc]);
                    const float la = -8.f * r * g_sp[cc]; const float a = __expf(la); const float u = __builtin_amdgcn_sqrtf(fmaxf(1.f - a * a, 0.f)) * gi * xc;
                    AA[t * 64 + d] = a; UU[t * 64 + d] = u; }
            }
        }
        __syncthreads();
        float hl[8], pl[8];
        {
            float h = 0.f, P = 1.f;
#pragma unroll
            for (int i = 0; i < 8; ++i) { const float a = AA[(8 * wave + i) * 64 + lane], u = UU[(8 * wave + i) * 64 + lane]; h = a * h + u; P *= a; hl[i] = h; pl[i] = P; }
            if (!SAMPLE) { COMB[(wave * 64 + lane) * 2] = P; COMB[(wave * 64 + lane) * 2 + 1] = h; }
        }
        if (!SAMPLE) __syncthreads();
        float carry;
        if (SAMPLE) carry = st_lru[(size_t)(bb * 8 + wave) * 512 + ch0 + lane];
        else { carry = HCAR[lane];
            float cp[7], chh[7];
#pragma unroll
            for (int s = 0; s < 7; ++s) { cp[s] = COMB[(s * 64 + lane) * 2]; chh[s] = COMB[(s * 64 + lane) * 2 + 1]; }
#pragma unroll
            for (int s = 0; s < 7; ++s) carry = (s < wave) ? cp[s] * carry + chh[s] : carry; }
        float hfin = 0.f;
#pragma unroll
        for (int i = 0; i < 8; ++i) { const int t = 8 * wave + i; const float h = hl[i] + pl[i] * carry; hfin = h;
            const float gr = bf1(GR[t * 64 + lane]);
            MG[(size_t)(rowbase + t0 + t) * DM + 512 + ch0 + lane] = tobf(h * gelu_tanh(gr)); }
        if (SAMPLE) out_lru[(size_t)(bb * 8 + wave) * 512 + ch0 + lane] = hfin;
        else if (tt == NT - 1 && wave == 7) out_lru[(size_t)bb * 512 + ch0 + lane] = hfin;
        __syncthreads();
        if (!SAMPLE && wave == 7) HCAR[lane] = hfin;
    }
}
#define LAS __attribute__((address_space(3)))
#define XB_TMO      128
#define XB_XCNT(j)  (256  + 64 * (j))
#define XB_XSUB(j)  (1280 + 64 * (j))
#define XB_XGEN(j)  (2304 + 64 * (j))
#define XB_TOP      3328
#define XB_TOPGEN   3392
#define XCD_BAR_WORDS 3456
#define XB_SPIN_CAP (1u << 18)

__device__ __forceinline__ unsigned xb_ld(unsigned* p)              { return __hip_atomic_load(p, __ATOMIC_RELAXED, __HIP_MEMORY_SCOPE_AGENT); }
__device__ __forceinline__ unsigned xb_add(unsigned* p, unsigned v) { return __hip_atomic_fetch_add(p, v, __ATOMIC_RELAXED, __HIP_MEMORY_SCOPE_AGENT); }
__device__ __forceinline__ unsigned xb_xcc_id() { return (unsigned)__builtin_amdgcn_s_getreg((3 << 11) | 20) & 0xFu; }
#define XB_SPIN(cond, bar) do { unsigned _sp = 0; while (cond) { __builtin_amdgcn_s_sleep(1); \
    if ((++_sp & 255u) == 0u) { if (xb_ld(&(bar)[XB_TMO])) break; if (_sp > XB_SPIN_CAP) { atomicAdd(&(bar)[XB_TMO], 1u); break; } } } } while (0)

struct XcdBarrier {
    unsigned* bar; unsigned x;
    volatile LAS unsigned* st;
};

__device__ __forceinline__ XcdBarrier xcd_barrier_post(unsigned* bar, volatile LAS unsigned* st) {
    XcdBarrier b; b.bar = bar; b.x = xb_xcc_id(); b.st = st;
    if (threadIdx.x == 0) (void)xb_add(&bar[XB_XCNT(b.x)], 1u);
    return b;
}
__device__ __forceinline__ void xcd_barrier_complete(unsigned* bar, unsigned x, unsigned& nloc, unsigned& nx) {
    const unsigned G = gridDim.x * gridDim.y * gridDim.z;
    unsigned sum, cnt, mine, sp = 0u;
    for (;;) {
        sum = 0u; cnt = 0u; mine = 0u;
#pragma unroll
        for (unsigned j = 0; j < 16; ++j) { const unsigned c = xb_ld(&bar[XB_XCNT(j)]); sum += c; cnt += (c > 0u) ? 1u : 0u; mine = (j == x) ? c : mine; }
        if (sum == G) break;
        __builtin_amdgcn_s_sleep(1);
        if ((++sp & 255u) == 0u) { if (xb_ld(&bar[XB_TMO])) break; if (sp > XB_SPIN_CAP) { atomicAdd(&bar[XB_TMO], 1u); break; } }
    }
    nloc = mine > 0u ? mine : 1u; nx = cnt > 0u ? cnt : 1u;
}

__device__ __forceinline__ void xcd_barrier(const XcdBarrier& b) {
    asm volatile("s_waitcnt vmcnt(0)" ::: "memory");
    __syncthreads();
    if (threadIdx.x == 0) {
        unsigned* bar = b.bar;
        __builtin_amdgcn_s_waitcnt(0);
        unsigned nloc = b.st[0], nx = b.st[1];
        if (nloc == 0u) { xcd_barrier_complete(bar, b.x, nloc, nx); b.st[0] = nloc; b.st[1] = nx; }
        const unsigned old = xb_add(&bar[XB_XSUB(b.x)], 1u);
        const unsigned gen = old / nloc;
        if (old + 1u == (gen + 1u) * nloc) {
            __builtin_amdgcn_fence(__ATOMIC_RELEASE, "agent");
            asm volatile("s_waitcnt vmcnt(0)" ::: "memory");
            const unsigned og = xb_add(&bar[XB_TOP], 1u);
            const unsigned tg = og / nx;
            if (og + 1u == (tg + 1u) * nx) xb_add(&bar[XB_TOPGEN], 1u);
            else XB_SPIN(xb_ld(&bar[XB_TOPGEN]) == tg, bar);
            __builtin_amdgcn_fence(__ATOMIC_ACQUIRE, "agent");
            xb_add(&bar[XB_XGEN(b.x)], 1u);
            asm volatile("s_waitcnt vmcnt(0)" ::: "memory");
        } else {
            XB_SPIN(xb_ld(&bar[XB_XGEN(b.x)]) == gen, bar);
            __builtin_amdgcn_fence(__ATOMIC_ACQUIRE, "agent");
            asm volatile("s_waitcnt vmcnt(0)" ::: "memory");
        }
    }
    __syncthreads();
}
#ifndef MXMASK
#define MXMASK 15
#endif
constexpr int MX_C = 128, MX_A = 512, MX_B = 128, MX_D = 128, MX_ALL = MX_C + MX_A + MX_B + MX_D;
__device__ __forceinline__ void mixer_phase(const Params& p, int l, unsigned char* lds, unsigned* ctr, volatile int* slot, int imask = 15) {
    const bfu* Z = (const bfu*)(p.ws + WS_ACT); bfu* MG = (bfu*)(p.ws + WS_MG);
    const float* qg = p.in[14] + l * 64; const float* kg = p.in[15] + l * 64; const float* sinks = p.in[16] + l * 8;
    const float* convw = p.in[17] + l * 2048; const float* convb = p.in[18] + l * 512;
    const float* wrg = p.in[19] + (size_t)l * 32768; const float* brg = p.in[20] + l * 512; const float* wig = p.in[21] + (size_t)l * 32768; const float* big = p.in[22] + l * 512;
    const float* lam = p.in[23] + l * 512;
    float* out = p.out;
    int cur = wq_next(ctr, slot);
    while (cur < MX_ALL) {
        unsigned pre = 0u;
        if (threadIdx.x == 0) pre = atomicAdd(ctr, 1u);
        int it = cur;
        if (it < MX_C) { if (imask & 1) lru_item<false>(it, Z, nullptr, nullptr, convw, convb, wrg, brg, wig, big, lam, MG, out + O_CP + (size_t)l * 16 * 1536, out + O_LP + (size_t)l * 16 * 512, lds); }
        else if ((it -= MX_C) < MX_A) { if (imask & 2) attn_item(it, Z, qg, kg, sinks, MG, out + O_KP + (size_t)l * 262144, out + O_VP + (size_t)l * 262144, lds); }
        else if ((it -= MX_A) < MX_B) { if (imask & 4) sattn_item(it, Z, p.in[2] + (size_t)l * 2097152, p.in[3] + (size_t)l * 2097152, qg, kg, sinks, MG, out + O_KS + (size_t)l * 2097152, out + O_VS + (size_t)l * 2097152, lds); }
        else { it -= MX_B; if (imask & 8) lru_item<true>(it, Z, p.in[4] + (size_t)l * 128 * 1536, p.in[5] + (size_t)l * 128 * 512, convw, convb, wrg, brg, wig, big, lam, MG, out + O_CS + (size_t)l * 128 * 1536, out + O_LS + (size_t)l * 128 * 512, lds); }
        __syncthreads();
        if (threadIdx.x == 0) *slot = (int)pre;
        __syncthreads();
        cur = *slot;
    }
}

__device__ __forceinline__ void grid_barrier(cg::grid_group& grid) {
    asm volatile("s_waitcnt vmcnt(0) lgkmcnt(0)" ::: "memory");
    __syncthreads();
    grid.sync();
    __builtin_amdgcn_fence(__ATOMIC_ACQUIRE, "agent");
    asm volatile("s_waitcnt vmcnt(0)" ::: "memory");
    __syncthreads();
}
#ifndef PH_HI
#define PH_HI 1000
#endif
#ifndef N_PHASES_CUT
#define N_PHASES_CUT 0
#endif
__global__ void __launch_bounds__(512, 2) fwd_kernel(Params p, int ph_lo, int ph_hi) {
    extern __shared__ __attribute__((aligned(16))) unsigned char lds[];
    cg::grid_group grid = cg::this_grid();
    volatile int* slot = (volatile int*)(lds + 131072);
    PG8_LAS unsigned char* lds3 = (PG8_LAS unsigned char*)lds;
    unsigned* ctl = (unsigned*)(p.ws + WS_CTL);
    const bfu* wsW = (const bfu*)(p.ws + WS_W); const float* mod = (const float*)(p.ws + WS_MOD);
    bfu* H = (bfu*)(p.ws + WS_H); bfu* MG = (bfu*)(p.ws + WS_MG); bfu* ACT = (bfu*)(p.ws + WS_ACT);
    float* X = p.out;
    const int G = gridDim.x, bx = blockIdx.x;
    if (threadIdx.x < 2) ((volatile LAS unsigned*)(lds3 + 131072 + 64))[threadIdx.x] = 0u;
    __syncthreads();
    const XcdBarrier xb = xcd_barrier_post(ctl + 4096, (volatile LAS unsigned*)(lds3 + 131072 + 64));
#define SEAM() do { if (ph_hi < 0) grid_barrier(grid); else xcd_barrier(xb); } while (0)
    int ph = 0;
#ifndef PHMASK
#define PHMASK 0xff
#endif
#ifndef DBG_IMASK
#define DBG_IMASK 1
#endif
#ifndef REPMASK
#define REPMASK 0
#endif
#define PHASE(id, ...) do { if (ph >= ph_lo && ph < ph_hi) { if constexpr ((PHMASK >> id) & 1) { const int nrep_ = ((REPMASK >> id) & 1) ? 2 : 1; \
    for (int rep_ = 0; rep_ < nrep_; ++rep_) { __VA_ARGS__; if (rep_ + 1 < nrep_) SEAM(); } } if (ph + 1 < ph_hi) SEAM(); } ++ph; } while (0)
    PHASE(0, prologue_phase(p, lds, ctl + 512 * rep_, slot));
    PHASE(7, { pg8::Gemm g{(const bfu*)(p.ws + WS_SC), (const bfu*)(p.ws + WS_WADA), 256, 2 * NMODC, 1024}; pg8::StaticOrder S; S.init(256, 2 * NMODC, G, bx);
               pg8::EpiMod E{(float*)(p.ws + WS_MOD), p.in[9]}; pg8::gemm_phase<pg8::EpiMod, pg8::StaticOrder, true, true>(lds3, g, S, E); });
    float* XS = X + (size_t)MP * DM; float* PART = (float*)(p.ws + 404 * MiB);
    bfu* XB = (bfu*)(p.ws + 448 * MiB);
    PHASE(1, norm_phase(p.in[0], p.in[1], mod, 0, 1, H, nullptr, 0, nullptr, nullptr));
    for (int l = 0; l < 2; ++l) {
        const bfu* wl = wsW + (size_t)l * W_LAYER; const float* modl = mod + (size_t)l * NCB * NMODC;
        const float* xP = l == 0 ? p.in[0] : X; const float* xS = l == 0 ? p.in[1] : XS;
        PHASE(2, { pg8::Gemm g{H, wl + W_UP1, MT, 5632, 1024}; pg8::StaticOrder S; S.init(MT, 5632, G, bx); pg8::EpiSwiglu E{ACT, DFF};
                pg8::gemm_phase<pg8::EpiSwiglu, pg8::StaticOrder, true, true>(lds3, g, S, E); });
        if (l == 0) PHASE(3, { pg8::Gemm g{ACT, wl + W_DN1, MT, 1024, DFF}; pg8::SplitOrder S; S.init(1024, DFF, G, bx); pg8::EpiResid<0> E{p.in[0], nullptr, nullptr, XB, modl + 2 * DM, 0.5f, PART};
                pg8::gemm_phase<pg8::EpiResid<0>, pg8::SplitOrder, true, true>(lds3, g, S, E); });
        else PHASE(3, { pg8::Gemm g{ACT, wl + W_DN1, MT, 1024, DFF}; pg8::SplitOrder S; S.init(1024, DFF, G, bx); pg8::EpiResid<1> E{nullptr, XB, nullptr, XB, modl + 2 * DM, 0.5f, PART};
                pg8::gemm_phase<pg8::EpiResid<1>, pg8::SplitOrder, true, true>(lds3, g, S, E); });
        PHASE(1, norm_phase(X, xS, modl, 3, 4, H, PART, DFF / 256, XS, XB));
        PHASE(4, { pg8::Gemm g{H, wl + W_IN, MT, INC, 1024}; pg8::StaticOrder S; S.init(MT, INC, G, bx); pg8::EpiPlainBf16 E{ACT, INC};
                pg8::gemm_phase<pg8::EpiPlainBf16, pg8::StaticOrder, true, true>(lds3, g, S, E); });
        PHASE(5, mixer_phase(p, l, lds, ctl + 64 * (1 + l) + 512 * rep_, slot, rep_ ? DBG_IMASK : 15));
        PHASE(6, mgnorm_phase(MG, MG, p.in[24] + l * 512, p.in[25] + l * 512));
        PHASE(3, { pg8::Gemm g{MG, wl + W_OUT, MT, 1024, 1024}; pg8::SplitOrder S; S.init(1024, 1024, G, bx); pg8::EpiResid<1> E{nullptr, XB, nullptr, XB, modl + 5 * DM, 1.0f, PART};
                pg8::gemm_phase<pg8::EpiResid<1>, pg8::SplitOrder, true, true>(lds3, g, S, E); });
        PHASE(1, norm_phase(X, XS, modl, 6, 7, H, PART, 4, XS, XB));
        PHASE(2, { pg8::Gemm g{H, wl + W_UP2, MT, 5632, 1024}; pg8::StaticOrder S; S.init(MT, 5632, G, bx); pg8::EpiSwiglu E{ACT, DFF};
                pg8::gemm_phase<pg8::EpiSwiglu, pg8::StaticOrder, true, true>(lds3, g, S, E); });
        if (l == 0) PHASE(3, { pg8::Gemm g{ACT, wl + W_DN2, MT, 1024, DFF}; pg8::SplitOrder S; S.init(1024, DFF, G, bx); pg8::EpiResid<1> E{nullptr, XB, nullptr, XB, modl + 8 * DM, 0.5f, PART};
                pg8::gemm_phase<pg8::EpiResid<1>, pg8::SplitOrder, true, true>(lds3, g, S, E); });
        else PHASE(3, { pg8::Gemm g{ACT, wl + W_DN2, MT, 1024, DFF}; pg8::SplitOrder S; S.init(1024, DFF, G, bx); pg8::EpiResid<2> E{nullptr, XB, X, nullptr, modl + 8 * DM, 0.5f, PART};
                pg8::gemm_phase<pg8::EpiResid<2>, pg8::SplitOrder, true, true>(lds3, g, S, E); });
        if (l == 0) PHASE(1, norm_phase(X, XS, mod + (size_t)NCB * NMODC, 0, 1, H, PART, DFF / 256, XS, XB));
        else PHASE(1, fix_phase(XS, PART, DFF / 256));
    }
#undef PHASE
}

extern "C" void kernel_launch(void* const* d_in, const int* in_sizes, int n_in, void* d_out, int out_size, void* d_ws, size_t ws_size, hipStream_t stream) {
    static int grid = 0;
    if (grid == 0) {
        if (n_in != 30 || ws_size < 512 * MiB) { fprintf(stderr, "kernel_launch: unexpected n_in %d / ws %zu\n", n_in, ws_size); grid = -1; return; }
        int dev = 0, cus = 0, per_cu = 0;
        hipGetDevice(&dev); hipDeviceGetAttribute(&cus, hipDeviceAttributeMultiprocessorCount, dev);
        if (hipFuncSetAttribute((const void*)fwd_kernel, hipFuncAttributeMaxDynamicSharedMemorySize, LDS_BYTES) != hipSuccess) { fprintf(stderr, "kernel_launch: hipFuncSetAttribute failed\n"); grid = -1; return; }
        hipOccupancyMaxActiveBlocksPerMultiprocessor(&per_cu, (const void*)fwd_kernel, 512, LDS_BYTES);
        if (per_cu < 1) { fprintf(stderr, "kernel_launch: occupancy query says %d\n", per_cu); per_cu = 1; }
        (void)hipGetLastError();
        grid = cus * 1;
    }
    if (grid < 0) return;
    hipMemsetAsync((char*)d_ws + WS_CTL, 0, 32768, stream);
    Params p{};
    for (int i = 0; i < 30; ++i) p.in[i] = (const float*)d_in[i];
    p.out = (float*)d_out; p.ws = (unsigned char*)d_ws;
    int lo = 0, hi = PH_HI;
    void* args[] = {&p, &lo, &hi};
    hipError_t e = hipLaunchCooperativeKernel((const void*)fwd_kernel, dim3(grid), dim3(512), args, LDS_BYTES, stream);
    if (e != hipSuccess) fprintf(stderr, "cooperative launch failed: %s (grid %d)\n", hipGetErrorString(e), grid);
}
```

```cpp
#include <hip/hip_runtime.h>
#include <hip/hip_cooperative_groups.h>
#include <cstdio>
#include <cstdint>
namespace cg = cooperative_groups;
namespace pg8 {
#define PG8_LAS __attribute__((address_space(3)))
typedef unsigned short bf16_t;
typedef short bf16x8 __attribute__((ext_vector_type(8)));
typedef float f32x4 __attribute__((ext_vector_type(4)));
typedef unsigned u32x4 __attribute__((ext_vector_type(4)));
typedef unsigned u32x2 __attribute__((ext_vector_type(2)));
constexpr int BM = 256, BK = 64, HALF = 128, HTB = HALF * BK * 2  , STAGE_BYTES = 8 * HTB, NXCD = 8, WGM = 8;

__host__ __device__ __forceinline__ int lds_byte(int r, int c) { const int st = (r >> 4) * 2 + (c >> 5), rr = r & 15, cc = c & 31, ob = rr * 64 + cc * 2; return st * 1024 + (ob ^ (((ob >> 9) & 1) << 5)); }
__host__ __device__ __forceinline__ void stage_rc(int b, int& R, int& C) { const int st = b / 1024, sb = b % 1024, swz = sb ^ (((sb >> 9) & 1) << 5); R = (st >> 1) * 16 + swz / 64; C = (st & 1) * 32 + (swz % 64) / 2; }
__host__ __device__ __forceinline__ int perm32(int rho) { const int n = rho >> 4, i = rho & 15; return 8 * (i >> 2) + 4 * n + (i & 3); }

struct Unit { int pm, pn, k0, nt; };
struct Gemm { const bf16_t* A; const bf16_t* Bt; int M, N, K; };

struct StaticOrder {
    int nM, nN, nwg, G, c;
    __host__ __device__ void init(int M, int N, int G_, int c_) { nM = M / BM; nN = N / BM; nwg = nM * nN; G = G_; c = c_; }
    __host__ __device__ bool next(int i, Unit& u) const {
        const long L = (long)i * G + c; if (L >= nwg) return false;
        int wgid = (int)L; { const int q = nwg / NXCD, r = nwg % NXCD, xcd = wgid % NXCD, off = wgid / NXCD; wgid = (xcd < r ? xcd * (q + 1) : r * (q + 1) + (xcd - r) * q) + off; }
        const int nig = WGM * nN, gid = wgid / nig, fm = gid * WGM, gsz = (nM - fm) < WGM ? (nM - fm) : WGM;
        u.pm = fm + ((wgid % nig) % gsz); u.pn = (wgid % nig) / gsz; u.k0 = 0; u.nt = 0; return true;
    }
    __device__ __forceinline__ void a_ready(const Unit&) const {}
    __device__ __forceinline__ void done(const Unit&) const {}
};
struct SplitOrder {
    StaticOrder so; int nfull, nch, nN, G, c;
    __host__ __device__ void init(int N, int K, int G_, int c_) { so.init(128 * BM, N, G_, c_); nN = N / BM; nfull = 128 * nN; nch = K / 256; G = G_; c = c_; }
    __host__ __device__ bool next(int i, Unit& u) const {
        const long L = (long)i * G + c;
        if (L < nfull) { const int nr = nfull / G; return so.next((nr * G == nfull && i < nr) ? nr - 1 - i : i, u); }
        const int j = (int)(L - nfull); if (j >= 4 * nN * nch) return false;
        const int ch = j / (4 * nN), rem = j % (4 * nN);
        u.pm = 128 + rem / nN; u.pn = rem % nN; u.k0 = 4 * ch; u.nt = 4; return true;
    }
    __device__ __forceinline__ void a_ready(const Unit&) const {}
    __device__ __forceinline__ void done(const Unit&) const {}
};


__device__ __forceinline__ unsigned cvt_pk_bf16(float lo, float hi) { unsigned r; asm volatile("v_cvt_pk_bf16_f32 %0, %1, %2" : "=v"(r) : "v"(lo), "v"(hi)); return r; }
typedef float f32x2 __attribute__((ext_vector_type(2)));
constexpr int MP_ROWS = 32768;
#ifndef RESID_GB
#define RESID_GB 4
#endif
struct EpiSwiglu {
    static constexpr bool PERM = true, AFTER_DRAIN = false;
    bf16_t* O; int ldc;
    __device__ __forceinline__ void operator()(const f32x4 (&acc)[2][2][4][2], const Unit& u, int wr, int wc, int fr, int fq) const {
        const int row0 = u.pm * BM + wr * 64 + fr, col0 = u.pn * 128 + wc * 32 + 8 * fq;
#pragma unroll
        for (int ai = 0; ai < 2; ++ai)
#pragma unroll
            for (int m = 0; m < 4; ++m) {
                bf16_t* p = O + (size_t)(row0 + ai * HALF + m * 16) * ldc + col0;
                float v[8];
#pragma unroll
                for (int n = 0; n < 2; ++n)
#pragma unroll
                    for (int e = 0; e < 4; ++e) { const float g = acc[ai][0][m][n][e], up = acc[ai][1][m][n][e];
                        v[n * 4 + e] = g * up * __builtin_amdgcn_rcpf(1.f + __expf(-g)); }
                u32x4 w; w.x = cvt_pk_bf16(v[0], v[1]); w.y = cvt_pk_bf16(v[2], v[3]); w.z = cvt_pk_bf16(v[4], v[5]); w.w = cvt_pk_bf16(v[6], v[7]);
                *(u32x4*)p = w;
            }
    }
};
struct EpiPlainBf16 {
    static constexpr bool PERM = true, AFTER_DRAIN = false;
    bf16_t* O; int ldc;
    __device__ __forceinline__ void operator()(const f32x4 (&acc)[2][2][4][2], const Unit& u, int wr, int wc, int fr, int fq) const {
        const int row0 = u.pm * BM + wr * 64 + fr, col0 = u.pn * BM + wc * 32 + 8 * fq;
#pragma unroll
        for (int ai = 0; ai < 2; ++ai)
#pragma unroll
            for (int m = 0; m < 4; ++m) {
                bf16_t* p = O + (size_t)(row0 + ai * HALF + m * 16) * ldc + col0;
#pragma unroll
                for (int bj = 0; bj < 2; ++bj) { const f32x4 v0 = acc[ai][bj][m][0], v1 = acc[ai][bj][m][1];
                    u32x4 w; w.x = cvt_pk_bf16(v0[0], v0[1]); w.y = cvt_pk_bf16(v0[2], v0[3]); w.z = cvt_pk_bf16(v1[0], v1[1]); w.w = cvt_pk_bf16(v1[2], v1[3]);
                    *(u32x4*)(p + bj * HALF) = w; }
            }
    }
};
template <int MODE> struct EpiResid {
    static constexpr bool PERM = true, AFTER_DRAIN = false;
    const float* resF; const bf16_t* resB; float* outF; bf16_t* outB; const float* gate; float coef; float* part;
    __device__ __forceinline__ void operator()(const f32x4 (&acc)[2][2][4][2], const Unit& u, int wr, int wc, int fr, int fq) const {
        const int row0 = u.pm * BM + wr * 64 + fr, col0 = u.pn * BM + wc * 32 + 8 * fq;
        if (u.nt != 0) {
            float* pb = part + (size_t)(u.k0 >> 2) * 1024 * 1024;
#pragma unroll
            for (int aim = 0; aim < 4; ++aim) { const int ai = aim >> 1, m0 = (aim & 1) * 2;
                f32x4 g[4][2][2];
#pragma unroll
                for (int m = m0; m < m0 + 2; ++m) { const int row = row0 + ai * HALF + m * 16 - MP_ROWS; const float* gp = gate + (size_t)(16 + (row >> 3)) * 9216 + col0;
#pragma unroll
                    for (int bj = 0; bj < 2; ++bj)
#pragma unroll
                        for (int n = 0; n < 2; ++n) g[m][bj][n] = *(const f32x4*)(gp + bj * HALF + n * 4); }
                asm volatile("" ::: "memory");
#pragma unroll
                for (int m = m0; m < m0 + 2; ++m) { const int row = row0 + ai * HALF + m * 16 - MP_ROWS; float* op = pb + (size_t)row * 1024 + col0;
#pragma unroll
                    for (int bj = 0; bj < 2; ++bj)
#pragma unroll
                        for (int n = 0; n < 2; ++n) *(f32x4*)(op + bj * HALF + n * 4) = (g[m][bj][n] * coef) * acc[ai][bj][m][n]; }
                asm volatile("" ::: "memory");
            }
            return;
        }
        const float* gp = gate + (size_t)(u.pm >> 3) * 9216 + col0;
        f32x4 gc[2][2];
#pragma unroll
        for (int bj = 0; bj < 2; ++bj)
#pragma unroll
            for (int n = 0; n < 2; ++n) gc[bj][n] = *(const f32x4*)(gp + bj * HALF + n * 4);
        asm volatile("" ::: "memory");
#pragma unroll
        for (int bj = 0; bj < 2; ++bj)
#pragma unroll
            for (int n = 0; n < 2; ++n) gc[bj][n] = gc[bj][n] * coef;
        constexpr int GB = (MODE == 0) ? 2 : RESID_GB;
#pragma unroll
        for (int g0 = 0; g0 < 8; g0 += GB) {
            f32x4 r[8][2][2]; u32x4 rb[8][2];
#pragma unroll
            for (int gi = g0; gi < g0 + GB; ++gi) { const int ai = gi >> 2, m = gi & 3; const size_t off = (size_t)(row0 + ai * HALF + m * 16) * 1024 + col0;
#pragma unroll
                for (int bj = 0; bj < 2; ++bj) {
                    if (MODE == 0) { r[gi][bj][0] = *(const f32x4*)(resF + off + bj * HALF); r[gi][bj][1] = *(const f32x4*)(resF + off + bj * HALF + 4); }
                    else rb[gi][bj] = *(const u32x4*)(resB + off + bj * HALF); } }
            asm volatile("" ::: "memory");
#pragma unroll
            for (int gi = g0; gi < g0 + GB; ++gi) { const int ai = gi >> 2, m = gi & 3; const size_t off = (size_t)(row0 + ai * HALF + m * 16) * 1024 + col0;
#pragma unroll
                for (int bj = 0; bj < 2; ++bj) {
                    f32x4 x0, x1;
                    if (MODE == 0) { x0 = r[gi][bj][0]; x1 = r[gi][bj][1]; }
                    else { const u32x4 w = rb[gi][bj];
                        x0 = (f32x4){__uint_as_float(w.x << 16), __uint_as_float(w.x & 0xffff0000u), __uint_as_float(w.y << 16), __uint_as_float(w.y & 0xffff0000u)};
                        x1 = (f32x4){__uint_as_float(w.z << 16), __uint_as_float(w.z & 0xffff0000u), __uint_as_float(w.w << 16), __uint_as_float(w.w & 0xffff0000u)}; }
                    const f32x4 o0 = x0 + gc[bj][0] * acc[ai][bj][m][0], o1 = x1 + gc[bj][1] * acc[ai][bj][m][1];
                    if (MODE == 2) { *(f32x4*)(outF + off + bj * HALF) = o0; *(f32x4*)(outF + off + bj * HALF + 4) = o1; }
                    else { u32x4 w; w.x = cvt_pk_bf16(o0[0], o0[1]); w.y = cvt_pk_bf16(o0[2], o0[3]); w.z = cvt_pk_bf16(o1[0], o1[1]); w.w = cvt_pk_bf16(o1[2], o1[3]); *(u32x4*)(outB + off + bj * HALF) = w; } } }
            asm volatile("" ::: "memory");
        }
    }
};
struct EpiMod {
    static constexpr bool PERM = false, AFTER_DRAIN = false;
    float* mod; const float* bada;
    __device__ __forceinline__ void operator()(const f32x4 (&acc)[2][2][4][2], const Unit& u, int wr, int wc, int fr, int fq) const {
        const int row0 = wr * 64 + fr, n0 = u.pn * BM + wc * 32 + 4 * fq, l = n0 / 9216, j0 = n0 - l * 9216;
        f32x4 bv[2][2];
#pragma unroll
        for (int bj = 0; bj < 2; ++bj)
#pragma unroll
            for (int n = 0; n < 2; ++n) bv[bj][n] = *(const f32x4*)(bada + (size_t)l * 9216 + j0 + bj * HALF + n * 16);
        asm volatile("" ::: "memory");
#pragma unroll
        for (int ai = 0; ai < 2; ++ai)
#pragma unroll
            for (int m = 0; m < 4; ++m) {
                const int row = row0 + ai * HALF + m * 16;
                if (row < 144) {
                    float* op = mod + ((size_t)l * 144 + row) * 9216 + j0;
#pragma unroll
                    for (int bj = 0; bj < 2; ++bj)
#pragma unroll
                        for (int n = 0; n < 2; ++n) { const int c = bj * HALF + n * 16; *(f32x4*)(op + c) = acc[ai][bj][m][n] + bv[bj][n]; }
                }
            }
    }
};
template <class Epi, class Sched, bool ALIGN_EPI = false, bool SP2 = false>
__device__ __forceinline__ void gemm_phase(PG8_LAS unsigned char* lds, const Gemm g, const Sched& S, const Epi& E) {
    int tid_ = threadIdx.x; asm volatile("" : "+v"(tid_));
    const int tid = tid_, wid = __builtin_amdgcn_readfirstlane(tid >> 6), lane = tid & 63, wr = wid >> 2, wc = wid & 3, fr = lane & 15, fq = lane >> 4;
    const int K = g.K, ntf = K / BK;
    unsigned voffA[2], voffB[2];
#pragma unroll
    for (int i = 0; i < 2; ++i) { int R, C; stage_rc(tid * 16 + i * 8192, R, C); const int Rb = Epi::PERM ? ((R & ~31) + perm32(R & 31)) : R;
        voffA[i] = (unsigned)(R * K + C) * 2u; voffB[i] = (unsigned)(Rb * K + C) * 2u; }
    const size_t kstep = (size_t)(BK * 2);
    const size_t hstep = (size_t)HALF * K * 2;
    const size_t tstep = 2 * hstep;
    const unsigned ldsw = (unsigned)wid * 1024u;
    const int aoff = lds_byte(wr * 64 + fr, fq * 8), boff = lds_byte(wc * 32 + fr, fq * 8);
#define PG8_SA(b, h) (((b) * 2 + (h)) * HTB)
#define PG8_SB(b, h) ((4 + (b) * 2 + (h)) * HTB)
#define PG8_STAGE(bufoff, gbase, voff) do { _Pragma("unroll") for (int _i = 0; _i < 2; ++_i) \
        __builtin_amdgcn_global_load_lds((const unsigned*)((const char*)(gbase) + (voff)[_i]), (PG8_LAS unsigned*)(lds + (bufoff) + ldsw + _i * 8192), 16, 0, 0); } while (0)
#define PG8_LDA(dst, b, h) do { _Pragma("unroll") for (int m = 0; m < 4; ++m) _Pragma("unroll") for (int k = 0; k < 2; ++k) dst[m][k] = *(const PG8_LAS bf16x8*)(lds + PG8_SA(b, h) + aoff + m * 2048 + k * 1024); } while (0)
#define PG8_LDB(dst, b, h) do { _Pragma("unroll") for (int n = 0; n < 2; ++n) _Pragma("unroll") for (int k = 0; k < 2; ++k) dst[n][k] = *(const PG8_LAS bf16x8*)(lds + PG8_SB(b, h) + boff + n * 2048 + k * 1024); } while (0)
#define PG8_MMA(ai, bj, At, Bt) do { __builtin_amdgcn_s_setprio(1); _Pragma("unroll") for (int m = 0; m < 4; ++m) _Pragma("unroll") for (int n = 0; n < 2; ++n) _Pragma("unroll") for (int k = 0; k < 2; ++k) \
        acc[ai][bj][m][n] = __builtin_amdgcn_mfma_f32_16x16x32_bf16(Bt[n][k], At[m][k], acc[ai][bj][m][n], 0, 0, 0); __builtin_amdgcn_s_setprio(0); } while (0)
#define PG8_WAIT_V(n) asm volatile("s_waitcnt vmcnt(" #n ")" ::: "memory")
#define PG8_WAIT_L(n) asm volatile("s_waitcnt lgkmcnt(" #n ")" ::: "memory")
#define PG8_BAR __builtin_amdgcn_s_barrier()
#define PG8_SCHED __builtin_amdgcn_sched_barrier(0)
    Unit cur, nxt; int ui = 0;
    if (!S.next(0, cur)) return;
    f32x4 acc[2][2][4][2];
#pragma unroll
    for (int a = 0; a < 2; ++a)
#pragma unroll
        for (int b = 0; b < 2; ++b)
#pragma unroll
            for (int m = 0; m < 4; ++m)
#pragma unroll
                for (int n = 0; n < 2; ++n) acc[a][b][m][n] = (f32x4){0.f, 0.f, 0.f, 0.f};
    bf16x8 At[4][2], B0[2][2], B1[2][2];
    int nt = cur.nt ? cur.nt : ntf;
    const char* cA = (const char*)g.A + (size_t)cur.pm * tstep + (size_t)cur.k0 * kstep; const char* cB = (const char*)g.Bt + (size_t)cur.pn * tstep + (size_t)cur.k0 * kstep;
    S.a_ready(cur);
    if constexpr (SP2) {
        PG8_STAGE(PG8_SB(0, 0), cB, voffB); PG8_STAGE(PG8_SB(0, 1), cB + hstep, voffB); PG8_STAGE(PG8_SA(0, 0), cA, voffA); PG8_STAGE(PG8_SA(0, 1), cA + hstep, voffA);
        if (wr == 1) PG8_BAR;
        PG8_WAIT_V(2); PG8_BAR;
        PG8_STAGE(PG8_SB(1, 0), cB + kstep, voffB); PG8_STAGE(PG8_SA(1, 0), cA + kstep, voffA); PG8_STAGE(PG8_SB(1, 1), cB + hstep + kstep, voffB);
        PG8_WAIT_V(6); PG8_BAR;
    } else {
        PG8_STAGE(PG8_SB(0, 0), cB, voffB); PG8_STAGE(PG8_SA(0, 0), cA, voffA); PG8_STAGE(PG8_SB(0, 1), cB + hstep, voffB); PG8_STAGE(PG8_SA(0, 1), cA + hstep, voffA);
        if (wr == 1) PG8_BAR;
        PG8_WAIT_V(4); PG8_BAR;
        PG8_STAGE(PG8_SB(1, 0), cB + kstep, voffB); PG8_STAGE(PG8_SA(1, 0), cA + kstep, voffA); PG8_STAGE(PG8_SB(1, 1), cB + hstep + kstep, voffB);
        PG8_WAIT_V(6); PG8_BAR;
    }
    for (;;) {
        const bool has_next = S.next(ui + 1, nxt);
        const char* nA = has_next ? (const char*)g.A + (size_t)nxt.pm * tstep + (size_t)nxt.k0 * kstep : cA; const char* nB = has_next ? (const char*)g.Bt + (size_t)nxt.pn * tstep + (size_t)nxt.k0 * kstep : cB;
        for (int t = 0; t < nt; t += 2) {
            const bool last = (t == nt - 2);
            const char* a1 = cA + (size_t)(t + 1) * kstep;
            const char* a2 = last ? nA : cA + (size_t)(t + 2) * kstep; const char* b2 = last ? nB : cB + (size_t)(t + 2) * kstep;
            const char* a3 = a2 + kstep; const char* b3 = b2 + kstep;
            if (last && has_next) S.a_ready(nxt);
            if constexpr (SP2) {
            PG8_LDB(B0, 0, 0); PG8_LDB(B1, 0, 1); PG8_SCHED; PG8_LDA(At, 0, 0); PG8_STAGE(PG8_SA(1, 1), a1 + hstep, voffA);
            PG8_WAIT_V(8); PG8_WAIT_L(0); PG8_BAR; PG8_MMA(0, 0, At, B0); PG8_MMA(0, 1, At, B1); PG8_BAR; PG8_SCHED;
            PG8_LDA(At, 0, 1); PG8_STAGE(PG8_SB(0, 0), b2, voffB); PG8_STAGE(PG8_SB(0, 1), b2 + hstep, voffB); PG8_STAGE(PG8_SA(0, 0), a2, voffA);
            PG8_WAIT_V(8); PG8_WAIT_L(0); PG8_BAR; PG8_MMA(1, 0, At, B0); PG8_MMA(1, 1, At, B1); PG8_BAR; PG8_SCHED;
            PG8_LDB(B0, 1, 0); PG8_LDB(B1, 1, 1); PG8_SCHED; PG8_LDA(At, 1, 0); PG8_STAGE(PG8_SA(0, 1), a2 + hstep, voffA);
            PG8_WAIT_V(8); PG8_WAIT_L(0); PG8_BAR; PG8_MMA(0, 0, At, B0); PG8_MMA(0, 1, At, B1); PG8_BAR; PG8_SCHED;
            PG8_LDA(At, 1, 1); PG8_STAGE(PG8_SB(1, 0), b3, voffB); PG8_STAGE(PG8_SB(1, 1), b3 + hstep, voffB); PG8_STAGE(PG8_SA(1, 0), a3, voffA);
            PG8_WAIT_V(8); PG8_WAIT_L(0); PG8_BAR; PG8_MMA(1, 0, At, B0); PG8_MMA(1, 1, At, B1); PG8_BAR; PG8_SCHED;
            } else {
            PG8_LDB(B0, 0, 0); PG8_SCHED; PG8_LDA(At, 0, 0); PG8_STAGE(PG8_SA(1, 1), a1 + hstep, voffA);
            PG8_WAIT_L(8); PG8_BAR; PG8_WAIT_L(0); PG8_MMA(0, 0, At, B0); PG8_BAR; PG8_SCHED;
            PG8_LDB(B1, 0, 1); PG8_STAGE(PG8_SB(0, 0), b2, voffB);
            PG8_BAR; PG8_WAIT_L(0); PG8_MMA(0, 1, At, B1); PG8_BAR;
            PG8_LDA(At, 0, 1); PG8_STAGE(PG8_SA(0, 0), a2, voffA);
            PG8_BAR; PG8_WAIT_L(0); PG8_MMA(1, 0, At, B0); PG8_BAR; PG8_SCHED;
            PG8_STAGE(PG8_SB(0, 1), b2 + hstep, voffB);
            PG8_WAIT_V(6); PG8_BAR; PG8_MMA(1, 1, At, B1); PG8_BAR;
            PG8_LDB(B0, 1, 0); PG8_SCHED; PG8_LDA(At, 1, 0); PG8_STAGE(PG8_SA(0, 1), a2 + hstep, voffA);
            PG8_WAIT_L(8); PG8_BAR; PG8_WAIT_L(0); PG8_MMA(0, 0, At, B0); PG8_BAR; PG8_SCHED;
            PG8_LDB(B1, 1, 1); PG8_STAGE(PG8_SB(1, 0), b3, voffB);
            PG8_BAR; PG8_WAIT_L(0); PG8_MMA(0, 1, At, B1); PG8_BAR;
            PG8_LDA(At, 1, 1); PG8_STAGE(PG8_SA(1, 0), a3, voffA);
            PG8_BAR; PG8_WAIT_L(0); PG8_MMA(1, 0, At, B0); PG8_BAR; PG8_SCHED;
            PG8_STAGE(PG8_SB(1, 1), b3 + hstep, voffB);
            PG8_WAIT_V(6); PG8_BAR; PG8_MMA(1, 1, At, B1); PG8_BAR;
            }
        }
        if constexpr (ALIGN_EPI) { if (wr == 0) PG8_BAR; }
        if constexpr (!Epi::AFTER_DRAIN) { E(acc, cur, wr, wc, fr, fq); S.done(cur); }
        if (!has_next) break;
#pragma unroll
        for (int a = 0; a < 2; ++a)
#pragma unroll
            for (int b = 0; b < 2; ++b)
#pragma unroll
                for (int m = 0; m < 4; ++m)
#pragma unroll
                    for (int n = 0; n < 2; ++n) acc[a][b][m][n] = (f32x4){0.f, 0.f, 0.f, 0.f};
        cur = nxt; cA = nA; cB = nB; ++ui; nt = cur.nt ? cur.nt : ntf;
        if constexpr (ALIGN_EPI) { if (wr == 1) PG8_BAR; }
    }
    PG8_WAIT_V(0);
    if constexpr (!ALIGN_EPI) { if (wr == 0) PG8_BAR; }
    PG8_BAR;
    if constexpr (Epi::AFTER_DRAIN) { E.fused(acc, cur, wr, wc, fr, fq, lds, wid, lane); S.done(cur); }
#undef PG8_SA
#undef PG8_SB
#undef PG8_STAGE
#undef PG8_LDA
#undef PG8_LDB
#undef PG8_MMA
#undef PG8_WAIT_V
#undef PG8_WAIT_L
#undef PG8_BAR
#undef PG8_SCHED
}
}
typedef unsigned short bfu;
typedef short s16x8 __attribute__((ext_vector_type(8)));
typedef float f4 __attribute__((ext_vector_type(4)));
typedef float f16v __attribute__((ext_vector_type(16)));
typedef unsigned u4 __attribute__((ext_vector_type(4)));
typedef unsigned u2 __attribute__((ext_vector_type(2)));
#define LAS3 __attribute__((address_space(3)))

constexpr int DM = 1024, MP = 32768, MS = 1024, MT = MP + MS, DFF = 2816, INC = 1792, NMODC = 9216, NCB = 144;
constexpr size_t MiB = 1u << 20;
constexpr size_t WS_CTL = 0, WS_MOD = 1 * MiB, WS_W = 12 * MiB, WS_H = 90 * MiB, WS_MG = 156 * MiB, WS_ACT = 222 * MiB, WS_END = 404 * MiB;
constexpr size_t W_UP1 = 0, W_DN1 = W_UP1 + (size_t)5632 * 1024, W_IN = W_DN1 + (size_t)1024 * 2816, W_OUT = W_IN + (size_t)1792 * 1024,
                 W_UP2 = W_OUT + (size_t)1024 * 1024, W_DN2 = W_UP2 + (size_t)5632 * 1024, W_LAYER = W_DN2 + (size_t)1024 * 2816;
static_assert(WS_W + 2 * W_LAYER * 2 <= WS_H, "weights fit");
constexpr size_t O_YP = 0, O_YS = 33554432, O_KP = 34603008, O_VP = O_KP + 524288, O_CP = O_VP + 524288, O_LP = O_CP + 49152, O_KS = O_LP + 16384,
                 O_VS = O_KS + 4194304, O_CS = O_VS + 4194304, O_LS = O_CS + 393216;
constexpr int LDS_BYTES = 131072 + 256;

typedef float f32x2_t __attribute__((ext_vector_type(2))); typedef __bf16 bf16x2_t __attribute__((ext_vector_type(2)));
__device__ __forceinline__ unsigned pkbf(float lo, float hi) { f32x2_t v = {lo, hi}; bf16x2_t b = __builtin_convertvector(v, bf16x2_t); return __builtin_bit_cast(unsigned, b); }
__device__ __forceinline__ float bflo(unsigned w) { return __uint_as_float(w << 16); }
__device__ __forceinline__ float bfhi(unsigned w) { return __uint_as_float(w & 0xffff0000u); }
__device__ __forceinline__ float bf1(bfu b) { return __uint_as_float(((unsigned)b) << 16); }
__device__ __forceinline__ bfu tobf(float f) { return (bfu)(pkbf(f, 0.f) & 0xffffu); }
__device__ __forceinline__ float sigm(float x) { return __builtin_amdgcn_rcpf(1.f + __expf(-x)); }
__device__ __forceinline__ float gelu_tanh(float x) { const float t = 0.7978845608028654f * (x + 0.044715f * x * x * x); return x * sigm(2.f * t); }
__device__ __forceinline__ int crow(int r, int hi) { return (r & 3) + 8 * (r >> 2) + 4 * hi; }

struct Params { const float* in[30]; float* out; unsigned char* ws; };

__device__ __forceinline__ int wq_next(unsigned* ctr, volatile int* slot) {
    __syncthreads();
    if (threadIdx.x == 0) *slot = (int)atomicAdd(ctr, 1u);
    __syncthreads();
    return *slot;
}

__device__ __forceinline__ void transpose_item(const float* W, int K, int N, bfu* WT, int mode, float* scr, int item, int lane) {
    const int nblk = N / 32, kb = item / nblk, nb = item % nblk, k0 = 64 * kb, n0 = 32 * nb;
    const int r0 = mode == 0 ? n0 : ((n0 >> 7) * 256 + (n0 & 127) + (mode == 2 ? 128 : 0));
    float wv[32];
#pragma unroll
    for (int i = 0; i < 32; ++i) { const int kk = 2 * i + (lane >> 5); wv[i] = __builtin_nontemporal_load(W + (size_t)(k0 + kk) * N + n0 + (lane & 31)); }
#pragma unroll
    for (int i = 0; i < 32; ++i) { const int kk = 2 * i + (lane >> 5); scr[kk * 33 + (lane & 31)] = wv[i]; }
    asm volatile("s_waitcnt lgkmcnt(0)" ::: "memory");
    const int c = lane & 7;
#pragma unroll
    for (int jj = 0; jj < 4; ++jj) { const int n = (lane >> 3) + 8 * jj; const float* s = scr + (8 * c) * 33 + n;
        u4 o; o.x = pkbf(s[0], s[33]); o.y = pkbf(s[66], s[99]); o.z = pkbf(s[132], s[165]); o.w = pkbf(s[198], s[231]);
        *(u4*)(WT + (size_t)(r0 + n) * K + k0 + 8 * c) = o; }
    asm volatile("s_waitcnt lgkmcnt(0)" ::: "memory");
}
constexpr int TI_BIG = 1408, TI_IN = 896, TI_OUT = 512, TI_ADA = 4608, TI_LAYER = 6 * TI_BIG + TI_IN + TI_OUT + TI_ADA;
constexpr int N_SC_ITEMS = 8, N_TR_WG_ITEMS = 2 * TI_LAYER / 8;
constexpr size_t WS_WADA = 404 * MiB, WS_SC = 440 * MiB;
__device__ __forceinline__ void prologue_phase(const Params& p, unsigned char* lds, unsigned* ctr, volatile int* slot) {
    int tid_ = threadIdx.x; asm volatile("" : "+v"(tid_));
    const int tid = tid_, lane = tid & 63, w = tid >> 6;
    bfu* wsW = (bfu*)(p.ws + WS_W); bfu* wada = (bfu*)(p.ws + WS_WADA); bfu* SC = (bfu*)(p.ws + WS_SC);
    for (;;) {
        const int it = wq_next(ctr, slot);
        if (it >= N_SC_ITEMS + N_TR_WG_ITEMS) break;
        if (it < N_SC_ITEMS) {
            const int row = it * 32 + (tid >> 4), c0 = (tid & 15) * 64;
            const float* src = row < 16 ? p.in[6] + (size_t)row * 1024 : (row < 144 ? p.in[7] + (size_t)(row - 16) * 1024 : nullptr);
#pragma unroll
            for (int e = 0; e < 16; ++e) { f4 c = src ? *(const f4*)(src + c0 + 4 * e) : (f4){0.f, 0.f, 0.f, 0.f};
                u2 o; o.x = pkbf(c.x * sigm(c.x), c.y * sigm(c.y)); o.y = pkbf(c.z * sigm(c.z), c.w * sigm(c.w));
                *(u2*)(SC + (size_t)row * 1024 + c0 + 4 * e) = o; }
            continue; }
        int wi = (it - N_SC_ITEMS) * 8 + w; const int l = wi / TI_LAYER; int r = wi % TI_LAYER;
        bfu* wl = wsW + (size_t)l * W_LAYER; float* scr = (float*)lds + w * (64 * 33);
        if (r < TI_ADA) { transpose_item(p.in[8] + (size_t)l * 1024 * NMODC, 1024, NMODC, wada + (size_t)l * NMODC * 1024, 0, scr, r, lane); continue; } r -= TI_ADA;
        if (r < TI_BIG) { transpose_item(p.in[10] + (size_t)l * 1024 * DFF, 1024, DFF, wl + W_UP1, 1, scr, r, lane); continue; } r -= TI_BIG;
        if (r < TI_BIG) { transpose_item(p.in[11] + (size_t)l * 1024 * DFF, 1024, DFF, wl + W_UP1, 2, scr, r, lane); continue; } r -= TI_BIG;
        if (r < TI_BIG) { transpose_item(p.in[12] + (size_t)l * DFF * 1024, DFF, 1024, wl + W_DN1, 0, scr, r, lane); continue; } r -= TI_BIG;
        if (r < TI_IN) { transpose_item(p.in[13] + (size_t)l * 1024 * INC, 1024, INC, wl + W_IN, 0, scr, r, lane); continue; } r -= TI_IN;
        if (r < TI_OUT) { transpose_item(p.in[26] + (size_t)l * 1024 * 1024, 1024, 1024, wl + W_OUT, 0, scr, r, lane); continue; } r -= TI_OUT;
        if (r < TI_BIG) { transpose_item(p.in[27] + (size_t)l * 1024 * DFF, 1024, DFF, wl + W_UP2, 1, scr, r, lane); continue; } r -= TI_BIG;
        if (r < TI_BIG) { transpose_item(p.in[28] + (size_t)l * 1024 * DFF, 1024, DFF, wl + W_UP2, 2, scr, r, lane); continue; } r -= TI_BIG;
        transpose_item(p.in[29] + (size_t)l * DFF * 1024, DFF, 1024, wl + W_DN2, 0, scr, r, lane);
    }
}

__device__ __forceinline__ float wave_sum(float v) {
#pragma unroll
    for (int o = 1; o < 64; o <<= 1) v += __shfl_xor(v, o);
    return v;
}
__device__ __forceinline__ void norm_phase(const float* xP, const float* xS, const float* modl, int shi, int sci, bfu* H, const float* part, int nch, float* XSout, const bfu* XbP) {
    int tid_ = threadIdx.x; asm volatile("" : "+v"(tid_));
    const int lane = tid_ & 63, gw = blockIdx.x * 8 + (tid_ >> 6), NGW = gridDim.x * 8;
    f4 v[4], sh[4], sc[4];
    auto ld = [&](int row, f4 (&vv)[4], f4 (&shh)[4], f4 (&scc)[4]) {
        const bool pr = row < MP;
        const f4* xr = (const f4*)(pr ? xP + (size_t)row * DM : xS + (size_t)(row - MP) * DM) + lane;
        const int cb = pr ? (row >> 11) : 16 + ((row - MP) >> 3);
        const f4* shp = (const f4*)(modl + (size_t)cb * NMODC + shi * DM) + lane; const f4* scp = (const f4*)(modl + (size_t)cb * NMODC + sci * DM) + lane;
#pragma unroll
        for (int j = 0; j < 4; ++j) { shh[j] = shp[64 * j]; scc[j] = scp[64 * j]; }
        if (XbP != nullptr && pr) {
            const u2* hr = (const u2*)(XbP + (size_t)row * DM) + lane;
#pragma unroll
            for (int j = 0; j < 4; ++j) { const u2 w = __builtin_nontemporal_load(hr + 64 * j); vv[j] = (f4){bflo(w.x), bfhi(w.x), bflo(w.y), bfhi(w.y)}; }
        } else {
#pragma unroll
            for (int j = 0; j < 4; ++j) vv[j] = __builtin_nontemporal_load(xr + 64 * j);
        }
    };
    if (gw < MT) ld(gw, v, sh, sc);
    for (int row = gw; row < MT; row += NGW) {
        f4 vn[4], shn[4], scn[4];
        const int nrow = row + NGW;
        if (nrow < MT) ld(nrow, vn, shn, scn);
        if (nch > 0 && row >= MP) {
            const f4* pp = (const f4*)(part + (size_t)(row - MP) * DM) + lane;
            for (int ch = 0; ch < nch; ch += 4) {
                f4 t[4][4];
#pragma unroll
                for (int c2 = 0; c2 < 4; ++c2)
#pragma unroll
                    for (int j = 0; j < 4; ++j) t[c2][j] = (ch + c2 < nch) ? pp[(size_t)(ch + c2) * (1024 * 1024 / 4) + 64 * j] : (f4){0.f, 0.f, 0.f, 0.f};
#pragma unroll
                for (int c2 = 0; c2 < 4; ++c2)
#pragma unroll
                    for (int j = 0; j < 4; ++j) v[j] += t[c2][j];
            }
            f4* xo = (f4*)(XSout + (size_t)(row - MP) * DM) + lane;
#pragma unroll
            for (int j = 0; j < 4; ++j) xo[64 * j] = v[j];
        }
        float s = 0.f;
#pragma unroll
        for (int j = 0; j < 4; ++j) s += (v[j].x * v[j].x + v[j].y * v[j].y) + (v[j].z * v[j].z + v[j].w * v[j].w);
        const float rstd = rsqrtf(wave_sum(s) * (1.f / DM) + 1e-6f);
        u2* o8 = (u2*)(H + (size_t)row * DM) + lane;
#pragma unroll
        for (int j = 0; j < 4; ++j) { const f4 y = v[j] * rstd * (sc[j] + 1.f) + sh[j];
            u2 o; o.x = pkbf(y.x, y.y); o.y = pkbf(y.z, y.w); o8[64 * j] = o; }
#pragma unroll
        for (int j = 0; j < 4; ++j) { v[j] = vn[j]; sh[j] = shn[j]; sc[j] = scn[j]; }
    }
}
__device__ __forceinline__ void mgnorm_phase(const bfu* MG, bfu* OUT, const float* betaA, const float* betaL) {
    int tid_ = threadIdx.x; asm volatile("" : "+v"(tid_));
    const int lane = tid_ & 63, gw = blockIdx.x * 8 + (tid_ >> 6), NGW = gridDim.x * 8;
    const float* bp = lane < 32 ? betaA + lane * 16 : betaL + (lane - 32) * 16;
    float be[16];
#pragma unroll
    for (int e = 0; e < 4; ++e) { const f4 b = ((const f4*)bp)[e]; be[4 * e] = b.x; be[4 * e + 1] = b.y; be[4 * e + 2] = b.z; be[4 * e + 3] = b.w; }
    for (int row0 = gw; row0 < MT; row0 += 4 * NGW) {
        u4 ra[4], rb[4];
#pragma unroll
        for (int i = 0; i < 4; ++i) { const int row = row0 + i * NGW; if (row < MT) { const u4* rp = (const u4*)(MG + (size_t)row * DM + lane * 16); ra[i] = rp[0]; rb[i] = rp[1]; } }
#pragma unroll
        for (int i = 0; i < 4; ++i) { const int row = row0 + i * NGW; if (row < MT) {
            const unsigned wv[8] = {ra[i].x, ra[i].y, ra[i].z, ra[i].w, rb[i].x, rb[i].y, rb[i].z, rb[i].w};
            float f[16]; float s = 0.f;
#pragma unroll
            for (int e = 0; e < 8; ++e) { f[2 * e] = bflo(wv[e]); f[2 * e + 1] = bfhi(wv[e]); s += f[2 * e] * f[2 * e] + f[2 * e + 1] * f[2 * e + 1]; }
#pragma unroll
            for (int o = 1; o < 32; o <<= 1) s += __shfl_xor(s, o);
            const float rstd = rsqrtf(s * (1.f / 512.f) + 1e-6f);
            u4 oa, ob;
            oa.x = pkbf(f[0] * rstd * be[0], f[1] * rstd * be[1]); oa.y = pkbf(f[2] * rstd * be[2], f[3] * rstd * be[3]);
            oa.z = pkbf(f[4] * rstd * be[4], f[5] * rstd * be[5]); oa.w = pkbf(f[6] * rstd * be[6], f[7] * rstd * be[7]);
            ob.x = pkbf(f[8] * rstd * be[8], f[9] * rstd * be[9]); ob.y = pkbf(f[10] * rstd * be[10], f[11] * rstd * be[11]);
            ob.z = pkbf(f[12] * rstd * be[12], f[13] * rstd * be[13]); ob.w = pkbf(f[14] * rstd * be[14], f[15] * rstd * be[15]);
            u4* wp = (u4*)(OUT + (size_t)row * DM + lane * 16); wp[0] = oa; wp[1] = ob; } }
    }
}
__device__ __forceinline__ void fix_phase(float* XS, const float* part, int nch) {
    int tid_ = threadIdx.x; asm volatile("" : "+v"(tid_));
    const int lane = tid_ & 63, gw = blockIdx.x * 8 + (tid_ >> 6), NGW = gridDim.x * 8;
    for (int row = gw; row < MS; row += NGW) {
        f4* xr = (f4*)(XS + (size_t)row * DM) + lane; const f4* pp = (const f4*)(part + (size_t)row * DM) + lane;
        f4 v[4];
#pragma unroll
        for (int j = 0; j < 4; ++j) v[j] = xr[64 * j];
        for (int ch = 0; ch < nch; ch += 4) {
            f4 t[4][4];
#pragma unroll
            for (int c2 = 0; c2 < 4; ++c2)
#pragma unroll
                for (int j = 0; j < 4; ++j) t[c2][j] = (ch + c2 < nch) ? pp[(size_t)(ch + c2) * (1024 * 1024 / 4) + 64 * j] : (f4){0.f, 0.f, 0.f, 0.f};
#pragma unroll
            for (int c2 = 0; c2 < 4; ++c2)
#pragma unroll
                for (int j = 0; j < 4; ++j) v[j] += t[c2][j];
        }
#pragma unroll
        for (int j = 0; j < 4; ++j) xr[64 * j] = v[j];
    }
}
__device__ __forceinline__ void attn_item(int idx, const bfu* Z, const float* qg, const float* kg, const float* sinks, bfu* MG, float* outk, float* outv, unsigned char* lds) {
    int tid_ = threadIdx.x; asm volatile("" : "+v"(tid_));
    const int tid = tid_, lane = tid & 63, wave = __builtin_amdgcn_readfirstlane(tid >> 6);
    const int b = idx >> 5, nb = (idx >> 1) & 15, kvh = idx & 1, R0 = b * 2048 + nb * 128;
    bfu* Ks = (bfu*)lds;
    bfu* Vt = (bfu*)(lds + 36864);
#ifdef DBG_ZERO_LDS
    for (int i = tid; i < 70656 / 16; i += 512) ((u4*)lds)[i] = (u4){0u, 0u, 0u, 0u};
    __syncthreads();
#endif
    {
        const int kr = tid >> 1, half = tid & 1;
        const bool ok = (nb > 0) || (kr >= 128);
        u4 kw[4], vw[4];
        if (ok) { const u4* kp = (const u4*)(Z + (size_t)(R0 - 128 + kr) * INC + 512 + kvh * 64 + half * 32); const u4* vp = (const u4*)(Z + (size_t)(R0 - 128 + kr) * INC + 640 + kvh * 64 + half * 32);
#pragma unroll
            for (int e = 0; e < 4; ++e) { kw[e] = kp[e]; vw[e] = vp[e]; } }
        else {
#pragma unroll
            for (int e = 0; e < 4; ++e) { kw[e] = (u4){0u, 0u, 0u, 0u}; vw[e] = (u4){0u, 0u, 0u, 0u}; } }
        float kf[32]; float ss = 0.f;
#pragma unroll
        for (int e = 0; e < 4; ++e) { const unsigned ww[4] = {kw[e].x, kw[e].y, kw[e].z, kw[e].w};
#pragma unroll
            for (int t = 0; t < 4; ++t) { kf[8 * e + 2 * t] = bflo(ww[t]); kf[8 * e + 2 * t + 1] = bfhi(ww[t]); } }
#pragma unroll
        for (int e = 0; e < 32; ++e) ss += kf[e] * kf[e];
        ss += __shfl_xor(ss, 1);
        const float rs = rsqrtf(ss * (1.f / 64.f) + 1e-6f);
#pragma unroll
        for (int e = 0; e < 32; ++e) kf[e] = kf[e] * rs * kg[half * 32 + e];
        u4* kd = (u4*)(Ks + kr * 72 + half * 32);
#pragma unroll
        for (int e = 0; e < 4; ++e) { u4 o; o.x = pkbf(kf[8 * e], kf[8 * e + 1]); o.y = pkbf(kf[8 * e + 2], kf[8 * e + 3]); o.z = pkbf(kf[8 * e + 4], kf[8 * e + 5]); o.w = pkbf(kf[8 * e + 6], kf[8 * e + 7]); kd[e] = o; }
#pragma unroll
        for (int e = 0; e < 4; ++e) { const unsigned ww[4] = {vw[e].x, vw[e].y, vw[e].z, vw[e].w};
#pragma unroll
            for (int t = 0; t < 4; ++t) { Vt[(half * 32 + 8 * e + 2 * t) * 264 + kr] = (bfu)(ww[t] & 0xffffu); Vt[(half * 32 + 8 * e + 2 * t + 1) * 264 + kr] = (bfu)(ww[t] >> 16); } }
        if (nb == 15 && kr >= 128) {
            float* ko = outk + ((size_t)(b * 128 + kr - 128) * 2 + kvh) * 64 + half * 32; float* vo = outv + ((size_t)(b * 128 + kr - 128) * 2 + kvh) * 64 + half * 32;
#pragma unroll
            for (int e = 0; e < 8; ++e) ((f4*)ko)[e] = (f4){kf[4 * e], kf[4 * e + 1], kf[4 * e + 2], kf[4 * e + 3]};
#pragma unroll
            for (int e = 0; e < 4; ++e) { const unsigned ww[4] = {vw[e].x, vw[e].y, vw[e].z, vw[e].w};
                ((f4*)vo)[2 * e] = (f4){bflo(ww[0]), bfhi(ww[0]), bflo(ww[1]), bfhi(ww[1])}; ((f4*)vo)[2 * e + 1] = (f4){bflo(ww[2]), bfhi(ww[2]), bflo(ww[3]), bfhi(ww[3])}; }
        }
    }
    __syncthreads();
    const int q = lane & 31, hi = lane >> 5;
#pragma unroll 1
    for (int itk = 0; itk < 2; ++itk) {
        const int task = wave + 8 * itk, g = task & 3, qs = task >> 2, h = kvh * 4 + g;
        int qq = q; asm volatile("" : "+v"(qq));
        const bfu* qp = Z + (size_t)(R0 + 32 * qs + q) * INC + h * 64 + hi * 8;
        float qv[32]; float ss = 0.f;
#pragma unroll
        for (int ds = 0; ds < 4; ++ds) { const u4 raw = *(const u4*)(qp + 16 * ds); const unsigned ww[4] = {raw.x, raw.y, raw.z, raw.w};
#pragma unroll
            for (int t = 0; t < 4; ++t) { qv[8 * ds + 2 * t] = bflo(ww[t]); qv[8 * ds + 2 * t + 1] = bfhi(ww[t]); } }
#pragma unroll
        for (int e = 0; e < 32; ++e) ss += qv[e] * qv[e];
        ss += __shfl_xor(ss, 32);
        const float qsc = rsqrtf(ss * (1.f / 64.f) + 1e-6f) * 0.125f;
        s16x8 qf[4];
#pragma unroll
        for (int ds = 0; ds < 4; ++ds) { const float* gp = qg + 16 * ds + 8 * hi; u4 o;
            o.x = pkbf(qv[8 * ds] * qsc * gp[0], qv[8 * ds + 1] * qsc * gp[1]); o.y = pkbf(qv[8 * ds + 2] * qsc * gp[2], qv[8 * ds + 3] * qsc * gp[3]);
            o.z = pkbf(qv[8 * ds + 4] * qsc * gp[4], qv[8 * ds + 5] * qsc * gp[5]); o.w = pkbf(qv[8 * ds + 6] * qsc * gp[6], qv[8 * ds + 7] * qsc * gp[7]);
            qf[ds] = __builtin_bit_cast(s16x8, o); }
        const float slope = exp2f(-(float)(h + 1)), sink = sinks[h];
        const int jt0 = (nb == 0) ? 4 : qs;
        f16v S[5];
        float m = sink;
#pragma unroll
        for (int x = 0; x < 5; ++x) {
            const int jt = qs + x;
            if (jt >= jt0) {
                f16v acc;
#pragma unroll
                for (int r = 0; r < 16; ++r) acc[r] = 0.f;
#pragma unroll
                for (int ds = 0; ds < 4; ++ds) { const s16x8 a = *(const s16x8*)(Ks + (32 * jt + q) * 72 + 16 * ds + 8 * hi); acc = __builtin_amdgcn_mfma_f32_32x32x16_bf16(a, qf[ds], acc, 0, 0, 0); }
#pragma unroll
                for (int r = 0; r < 16; ++r) { const int dist = 128 + 32 * qs + qq - (32 * jt + crow(r, hi)); const bool valid = dist >= 0 && dist <= 128;
                    const float sv = valid ? acc[r] - slope * (float)dist : -1e30f; S[x][r] = sv; m = fmaxf(m, sv); }
            } else {
#pragma unroll
                for (int r = 0; r < 16; ++r) S[x][r] = -1e30f;
            }
        }
        m = fmaxf(m, __shfl_xor(m, 32));
        float l = 0.f;
#pragma unroll
        for (int x = 0; x < 5; ++x)
#pragma unroll
            for (int r = 0; r < 16; ++r) { const float pe = __expf(S[x][r] - m); S[x][r] = pe; l += pe; }
        l += __shfl_xor(l, 32);
        l += __expf(sink - m);
        const float rinv = 1.f / l;
        f16v o0, o1;
#pragma unroll
        for (int r = 0; r < 16; ++r) { o0[r] = 0.f; o1[r] = 0.f; }
#pragma unroll
        for (int x = 0; x < 5; ++x) {
            const int jt = qs + x;
            if (jt >= jt0) {
#pragma unroll
                for (int s2 = 0; s2 < 2; ++s2) {
                    u4 pa; pa.x = pkbf(S[x][8 * s2], S[x][8 * s2 + 1]); pa.y = pkbf(S[x][8 * s2 + 2], S[x][8 * s2 + 3]); pa.z = pkbf(S[x][8 * s2 + 4], S[x][8 * s2 + 5]); pa.w = pkbf(S[x][8 * s2 + 6], S[x][8 * s2 + 7]);
                    const s16x8 A = __builtin_bit_cast(s16x8, pa);
                    const bfu* vp0 = Vt + q * 264 + 32 * jt + 16 * s2 + 4 * hi; const bfu* vp1 = vp0 + 32 * 264;
                    const u2 a0 = *(const u2*)vp0, a1 = *(const u2*)(vp0 + 8), b0 = *(const u2*)vp1, b1 = *(const u2*)(vp1 + 8);
                    const u4 B0 = {a0.x, a0.y, a1.x, a1.y}, B1 = {b0.x, b0.y, b1.x, b1.y};
                    o0 = __builtin_amdgcn_mfma_f32_32x32x16_bf16(A, __builtin_bit_cast(s16x8, B0), o0, 0, 0, 0);
                    o1 = __builtin_amdgcn_mfma_f32_32x32x16_bf16(A, __builtin_bit_cast(s16x8, B1), o1, 0, 0, 0);
                }
            }
        }
        bfu* op = MG + (size_t)(R0 + 32 * qs) * DM + h * 64 + q;
#pragma unroll
        for (int r = 0; r < 16; ++r) { const int qr = crow(r, hi); const float rl = __shfl(rinv, qr);
            op[(size_t)qr * DM] = tobf(o0[r] * rl); op[(size_t)qr * DM + 32] = tobf(o1[r] * rl); }
    }
}

__device__ __forceinline__ void sattn_item(int b, const bfu* Z, const float* ck, const float* cv, const float* qg, const float* kg, const float* sinks, bfu* MG, float* outk, float* outv, unsigned char* lds) {
    int tid_ = threadIdx.x; asm volatile("" : "+v"(tid_));
    const int tid = tid_, lane = tid & 63, wave = __builtin_amdgcn_readfirstlane(tid >> 6);
    bfu* KK = (bfu*)lds;
    bfu* VV = (bfu*)(lds + 34816);
    float* QS = (float*)(lds + 69632);
    float* SC = (float*)(lds + 86016);
    const float* ckb = ck + (size_t)b * 16384; const float* cvb = cv + (size_t)b * 16384;
    float* okb = outk + (size_t)b * 16384; float* ovb = outv + (size_t)b * 16384;
#pragma unroll
    for (int it = 0; it < 8; ++it) { const int i = tid + 512 * it, row = i >> 5, c4 = (i & 31) * 4;
        const f4 k4 = ((const f4*)ckb)[i], v4 = ((const f4*)cvb)[i];
        u2 o; o.x = pkbf(k4.x, k4.y); o.y = pkbf(k4.z, k4.w); *(u2*)(KK + row * 128 + c4) = o;
        o.x = pkbf(v4.x, v4.y); o.y = pkbf(v4.z, v4.w); *(u2*)(VV + row * 128 + c4) = o;
        if (row >= 8) { ((f4*)okb)[i - 256] = k4; ((f4*)ovb)[i - 256] = v4; } }
    {
        const int pair = tid >> 5, i = pair >> 1, kvh = pair & 1, dd = (tid & 31) * 2;
        const bfu* zr = Z + (size_t)(MP + 8 * b + i) * INC;
        const unsigned kwd = *(const unsigned*)(zr + 512 + kvh * 64 + dd), vwd = *(const unsigned*)(zr + 640 + kvh * 64 + dd);
        float k0 = bflo(kwd), k1 = bfhi(kwd); float ss = k0 * k0 + k1 * k1;
#pragma unroll
        for (int o = 1; o < 32; o <<= 1) ss += __shfl_xor(ss, o);
        const float rs = rsqrtf(ss * (1.f / 64.f) + 1e-6f);
        k0 = k0 * rs * kg[dd]; k1 = k1 * rs * kg[dd + 1];
        *(unsigned*)(KK + (128 + i) * 128 + kvh * 64 + dd) = pkbf(k0, k1); *(unsigned*)(VV + (128 + i) * 128 + kvh * 64 + dd) = vwd;
        float* ko = okb + (size_t)(120 + i) * 128 + kvh * 64 + dd; ko[0] = k0; ko[1] = k1;
        float* vo = ovb + (size_t)(120 + i) * 128 + kvh * 64 + dd; vo[0] = bflo(vwd); vo[1] = bfhi(vwd);
    }
    {
        const int pair = tid >> 3, i = pair >> 3, h = pair & 7, d0 = (tid & 7) * 8;
        const u4 raw = *(const u4*)(Z + (size_t)(MP + 8 * b + i) * INC + h * 64 + d0); const unsigned ww[4] = {raw.x, raw.y, raw.z, raw.w};
        float qv[8]; float ss = 0.f;
#pragma unroll
        for (int t = 0; t < 4; ++t) { qv[2 * t] = bflo(ww[t]); qv[2 * t + 1] = bfhi(ww[t]); ss += qv[2 * t] * qv[2 * t] + qv[2 * t + 1] * qv[2 * t + 1]; }
        ss += __shfl_xor(ss, 1); ss += __shfl_xor(ss, 2); ss += __shfl_xor(ss, 4);
        const float rs = rsqrtf(ss * (1.f / 64.f) + 1e-6f) * 0.125f;
#pragma unroll
        for (int e = 0; e < 8; ++e) QS[i * 512 + h * 64 + d0 + e] = qv[e] * rs * qg[d0 + e];
    }
    __syncthreads();
    {
        const int i = lane >> 3, h = lane & 7, kvh = h >> 2;
        float qr[64];
#pragma unroll
        for (int e = 0; e < 16; ++e) { const f4 t = *(const f4*)&QS[i * 512 + h * 64 + 4 * e]; qr[4 * e] = t.x; qr[4 * e + 1] = t.y; qr[4 * e + 2] = t.z; qr[4 * e + 3] = t.w; }
        const float slope = exp2f(-(float)(h + 1));
        for (int j = wave; j < 136; j += 8) {
            const u4* kp = (const u4*)(KK + j * 128 + kvh * 64); float d = 0.f;
#pragma unroll
            for (int c = 0; c < 8; ++c) { const u4 kw = kp[c]; const unsigned ww[4] = {kw.x, kw.y, kw.z, kw.w};
#pragma unroll
                for (int t = 0; t < 4; ++t) d += qr[8 * c + 2 * t] * bflo(ww[t]) + qr[8 * c + 2 * t + 1] * bfhi(ww[t]); }
            const int dist = 128 + i - j; const bool valid = dist >= 0 && dist <= 128;
            SC[lane * 137 + j] = valid ? d - slope * (float)dist : -1e30f;
        }
    }
    __syncthreads();
    {
        const int pair = tid >> 3, sub = tid & 7, h = pair & 7; const float sink = sinks[h];
        float m = sink;
        for (int j = sub; j < 136; j += 8) m = fmaxf(m, SC[pair * 137 + j]);
        m = fmaxf(m, __shfl_xor(m, 1)); m = fmaxf(m, __shfl_xor(m, 2)); m = fmaxf(m, __shfl_xor(m, 4));
        float l = 0.f;
        for (int j = sub; j < 136; j += 8) { const float pe = __expf(SC[pair * 137 + j] - m); SC[pair * 137 + j] = pe; l += pe; }
        l += __shfl_xor(l, 1); l += __shfl_xor(l, 2); l += __shfl_xor(l, 4);
        l += __expf(sink - m);
        const float rl = 1.f / l;
        for (int j = sub; j < 136; j += 8) SC[pair * 137 + j] *= rl;
    }
    __syncthreads();
    {
        const int pair = tid >> 3, dc = tid & 7, i = pair >> 3, h = pair & 7, kvh = h >> 2;
        float acc[8];
#pragma unroll
        for (int e = 0; e < 8; ++e) acc[e] = 0.f;
        for (int j = 0; j < 136; ++j) { const float pj = SC[pair * 137 + j]; const u4 vw = *(const u4*)(VV + j * 128 + kvh * 64 + dc * 8); const unsigned ww[4] = {vw.x, vw.y, vw.z, vw.w};
#pragma unroll
            for (int t = 0; t < 4; ++t) { acc[2 * t] += pj * bflo(ww[t]); acc[2 * t + 1] += pj * bfhi(ww[t]); } }
        u4 o; o.x = pkbf(acc[0], acc[1]); o.y = pkbf(acc[2], acc[3]); o.z = pkbf(acc[4], acc[5]); o.w = pkbf(acc[6], acc[7]);
        *(u4*)(MG + (size_t)(MP + 8 * b + i) * DM + h * 64 + dc * 8) = o;
    }
}
template <bool SAMPLE>
__device__ __forceinline__ void lru_item(int idx, const bfu* Z, const float* st_conv, const float* st_lru, const float* convw, const float* convb, const float* wrg, const float* brg,
                                         const float* wig, const float* big, const float* lam, bfu* MG, float* out_conv, float* out_lru, unsigned char* lds) {
    constexpr int L = SAMPLE ? 8 : 64, NT = SAMPLE ? 1 : 32, XROWS = SAMPLE ? 88 : 67;
    int tid_ = threadIdx.x; asm volatile("" : "+v"(tid_));
    const int tid = tid_, lane = tid & 63, wave = __builtin_amdgcn_readfirstlane(tid >> 6);
    const int n = idx & 7, bb = idx >> 3;
    const int rowbase = SAMPLE ? MP + bb * 64 : bb * 2048, ch0 = n * 64;
    float* XRS = (float*)lds;
    bfu* XCB = (bfu*)(lds + 22528);
    float* XCF = (float*)(lds + 31744);
    bfu* WRT = (bfu*)(lds + 48128);
    bfu* WIT = (bfu*)(lds + 57344);
    float* AA = (float*)(lds + 66560);
    float* UU = (float*)(lds + 82944);
    bfu* GR = (bfu*)(lds + 99328);
    float* COMB = (float*)(lds + 107520);
    float* HCAR = (float*)(lds + 111616);
    {
        const int c = tid >> 3, d0 = (tid & 7) * 8;
        const f4* rp = (const f4*)(wrg + (size_t)n * 4096 + c * 64 + d0); const f4* ip = (const f4*)(wig + (size_t)n * 4096 + c * 64 + d0);
        const f4 r0 = rp[0], r1 = rp[1], i0 = ip[0], i1 = ip[1];
        const float rv[8] = {r0.x, r0.y, r0.z, r0.w, r1.x, r1.y, r1.z, r1.w}, iv[8] = {i0.x, i0.y, i0.z, i0.w, i1.x, i1.y, i1.z, i1.w};
#pragma unroll
        for (int e = 0; e < 8; ++e) { WRT[(d0 + e) * 72 + c] = tobf(rv[e]); WIT[(d0 + e) * 72 + c] = tobf(iv[e]); }
        if (tid < 64) HCAR[tid] = 0.f;
    }
    const int ct_t = tid >> 3, ct_c = (tid & 7) * 8;
    float cw[4][8], cbv[8];
#pragma unroll
    for (int e = 0; e < 8; ++e) { cbv[e] = convb[ch0 + ct_c + e];
#pragma unroll
        for (int tap = 0; tap < 4; ++tap) cw[tap][e] = convw[tap * 512 + ch0 + ct_c + e]; }
    const int fr = lane & 15, fq = lane >> 4, rt = wave >> 1;
    float g_br[2], g_bi[2], g_sp[2];
#pragma unroll
    for (int cc = 0; cc < 2; ++cc) { const int d = 16 * (2 * (wave & 1) + cc) + fr; g_br[cc] = brg[ch0 + d]; g_bi[cc] = big[ch0 + d];
        const float x = -lam[ch0 + d]; g_sp[cc] = fmaxf(x, 0.f) + log1pf(__expf(-fabsf(x))); }
    u4 pxr[2], pgr; f4 pst[2][2];
    auto prefetch = [&](int tt) {
        const int t0 = tt * 64;
#pragma unroll
        for (int k = 0; k < 2; ++k) { const int i = tid + 512 * k; pxr[k] = (u4){0u, 0u, 0u, 0u};
            if (i < XROWS * 8) { const int xrow = i >> 3, cc = (i & 7) * 8;
                if (SAMPLE) { const int seg = xrow / 11, rr = xrow % 11;
                    if (rr < 3) { const f4* sp = (const f4*)(st_conv + ((size_t)(bb * 8 + seg) * 3 + rr) * 512 + ch0 + cc); pst[k][0] = sp[0]; pst[k][1] = sp[1]; }
                    else pxr[k] = *(const u4*)(Z + (size_t)(rowbase + seg * 8 + rr - 3) * INC + 768 + ch0 + cc); }
                else { const int trel = t0 - 3 + xrow; if (trel >= 0) pxr[k] = *(const u4*)(Z + (size_t)(rowbase + trel) * INC + 768 + ch0 + cc); } } }
        pgr = *(const u4*)(Z + (size_t)(rowbase + t0 + (tid >> 3)) * INC + 1280 + ch0 + (tid & 7) * 8);
    };
    prefetch(0);
    for (int tt = 0; tt < NT; ++tt) {
        const int t0 = tt * 64;
#pragma unroll
        for (int k = 0; k < 2; ++k) { const int i = tid + 512 * k;
            if (i < XROWS * 8) { const int xrow = i >> 3, cc = (i & 7) * 8; f4 lo, hi4;
                if (SAMPLE && (xrow % 11) < 3) { lo = pst[k][0]; hi4 = pst[k][1]; }
                else { lo = (f4){bflo(pxr[k].x), bfhi(pxr[k].x), bflo(pxr[k].y), bfhi(pxr[k].y)}; hi4 = (f4){bflo(pxr[k].z), bfhi(pxr[k].z), bflo(pxr[k].w), bfhi(pxr[k].w)}; }
                *(f4*)&XRS[xrow * 64 + cc] = lo; *(f4*)&XRS[xrow * 64 + cc + 4] = hi4; } }
        *(u4*)(GR + (tid >> 3) * 64 + (tid & 7) * 8) = pgr;
        __syncthreads();
        if (tt + 1 < NT) prefetch(tt + 1);
        if (SAMPLE) {
#pragma unroll
            for (int k = 0; k < 3; ++k) { const int i = tid + 512 * k, seg = i / 192, rr = (i % 192) >> 6, c = i & 63;
                out_conv[((size_t)(bb * 8 + seg) * 3 + rr) * 512 + ch0 + c] = XRS[(seg * 11 + 8 + rr) * 64 + c]; }
        } else if (tt == NT - 1) {
            if (tid < 192) { const int rr = tid >> 6, c = tid & 63; out_conv[((size_t)bb * 3 + rr) * 512 + ch0 + c] = XRS[(64 + rr) * 64 + c]; }
        }
        {
            const int seg = ct_t / L, tl = ct_t % L, xr0 = seg * (L + 3) + tl;
            float v[8];
#pragma unroll
            for (int e = 0; e < 8; ++e) v[e] = cbv[e];
#pragma unroll
            for (int tap = 0; tap < 4; ++tap) { const f4 a = *(const f4*)&XRS[(xr0 + tap) * 64 + ct_c], b4 = *(const f4*)&XRS[(xr0 + tap) * 64 + ct_c + 4];
                v[0] += cw[tap][0] * a.x; v[1] += cw[tap][1] * a.y; v[2] += cw[tap][2] * a.z; v[3] += cw[tap][3] * a.w;
                v[4] += cw[tap][4] * b4.x; v[5] += cw[tap][5] * b4.y; v[6] += cw[tap][6] * b4.z; v[7] += cw[tap][7] * b4.w; }
            *(f4*)&XCF[ct_t * 64 + ct_c] = (f4){v[0], v[1], v[2], v[3]}; *(f4*)&XCF[ct_t * 64 + ct_c + 4] = (f4){v[4], v[5], v[6], v[7]};
            u4 o; o.x = pkbf(v[0], v[1]); o.y = pkbf(v[2], v[3]); o.z = pkbf(v[4], v[5]); o.w = pkbf(v[6], v[7]);
            *(u4*)(XCB + ct_t * 72 + ct_c) = o;
        }
        __syncthreads();
        {
            const s16x8 a0 = *(const s16x8*)(XCB + (16 * rt + fr) * 72 + 8 * fq), a1 = *(const s16x8*)(XCB + (16 * rt + fr) * 72 + 32 + 8 * fq);
#pragma unroll
            for (int cc = 0; cc < 2; ++cc) { const int ct = 2 * (wave & 1) + cc;
                const bfu* wr_ = WRT + (16 * ct + fr) * 72 + 8 * fq; const bfu* wi_ = WIT + (16 * ct + fr) * 72 + 8 * fq;
                f4 ar = {0.f, 0.f, 0.f, 0.f}, ai = {0.f, 0.f, 0.f, 0.f};
                ar = __builtin_amdgcn_mfma_f32_16x16x32_bf16(a0, *(const s16x8*)wr_, ar, 0, 0, 0); ar = __builtin_amdgcn_mfma_f32_16x16x32_bf16(a1, *(const s16x8*)(wr_ + 32), ar, 0, 0, 0);
                ai = __builtin_amdgcn_mfma_f32_16x16x32_bf16(a0, *(const s16x8*)wi_, ai, 0, 0, 0); ai = __builtin_amdgcn_mfma_f32_16x16x32_bf16(a1, *(const s16x8*)(wi_ + 32), ai, 0, 0, 0);
                const int d = 16 * ct + fr;
#pragma unroll
                for (int e = 0; e < 4; ++e) { const int t = 16 * rt + 4 * fq + e; const float xc = XCF[t * 64 + d];
                    const float r = sigm(ar[e] + g_br[cc]), gi = sigm(ai[e] + g_bi[cc]);
                    const float la = -8.f * r * g_sp[cc]; const float a = __expf(la); const float u = __builtin_amdgcn_sqrtf(fmaxf(1.f - a * a, 0.f)) * gi * xc;
                    AA[t * 64 + d] = a; UU[t * 64 + d] = u; }
            }
        }
        __syncthreads();
        float hl[8], pl[8];
        {
            float h = 0.f, P = 1.f;
#pragma unroll
            for (int i = 0; i < 8; ++i) { const float a = AA[(8 * wave + i) * 64 + lane], u = UU[(8 * wave + i) * 64 + lane]; h = a * h + u; P *= a; hl[i] = h; pl[i] = P; }
            if (!SAMPLE) { COMB[(wave * 64 + lane) * 2] = P; COMB[(wave * 64 + lane) * 2 + 1] = h; }
        }
        if (!SAMPLE) __syncthreads();
        float carry;
        if (SAMPLE) carry = st_lru[(size_t)(bb * 8 + wave) * 512 + ch0 + lane];
        else { carry = HCAR[lane];
            float cp[7], chh[7];
#pragma unroll
            for (int s = 0; s < 7; ++s) { cp[s] = COMB[(s * 64 + lane) * 2]; chh[s] = COMB[(s * 64 + lane) * 2 + 1]; }
#pragma unroll
            for (int s = 0; s < 7; ++s) carry = (s < wave) ? cp[s] * carry + chh[s] : carry; }
        float hfin = 0.f;
#pragma unroll
        for (int i = 0; i < 8; ++i) { const int t = 8 * wave + i; const float h = hl[i] + pl[i] * carry; hfin = h;
            const float gr = bf1(GR[t * 64 + lane]);
            MG[(size_t)(rowbase + t0 + t) * DM + 512 + ch0 + lane] = tobf(h * gelu_tanh(gr)); }
        if (SAMPLE) out_lru[(size_t)(bb * 8 + wave) * 512 + ch0 + lane] = hfin;
        else if (tt == NT - 1 && wave == 7) out_lru[(size_t)bb * 512 + ch0 + lane] = hfin;
        __syncthreads();
        if (!SAMPLE && wave == 7) HCAR[lane] = hfin;
    }
}
#define LAS __attribute__((address_space(3)))
#define XB_TMO      128
#define XB_XCNT(j)  (256  + 64 * (j))
#define XB_XSUB(j)  (1280 + 64 * (j))
#define XB_XGEN(j)  (2304 + 64 * (j))
#define XB_TOP      3328
#define XB_TOPGEN   3392
#define XCD_BAR_WORDS 3456
#define XB_SPIN_CAP (1u << 18)

__device__ __forceinline__ unsigned xb_ld(unsigned* p)              { return __hip_atomic_load(p, __ATOMIC_RELAXED, __HIP_MEMORY_SCOPE_AGENT); }
__device__ __forceinline__ unsigned xb_add(unsigned* p, unsigned v) { return __hip_atomic_fetch_add(p, v, __ATOMIC_RELAXED, __HIP_MEMORY_SCOPE_AGENT); }
__device__ __forceinline__ unsigned xb_xcc_id() { return (unsigned)__builtin_amdgcn_s_getreg((3 << 11) | 20) & 0xFu; }
#define XB_SPIN(cond, bar) do { unsigned _sp = 0; while (cond) { __builtin_amdgcn_s_sleep(1); \
    if ((++_sp & 255u) == 0u) { if (xb_ld(&(bar)[XB_TMO])) break; if (_sp > XB_SPIN_CAP) { atomicAdd(&(bar)[XB_TMO], 1u); break; } } } } while (0)

struct XcdBarrier {
    unsigned* bar; unsigned x;
    volatile LAS unsigned* st;
};

__device__ __forceinline__ XcdBarrier xcd_barrier_post(unsigned* bar, volatile LAS unsigned* st) {
    XcdBarrier b; b.bar = bar; b.x = xb_xcc_id(); b.st = st;
    if (threadIdx.x == 0) (void)xb_add(&bar[XB_XCNT(b.x)], 1u);
    return b;
}
__device__ __forceinline__ void xcd_barrier_complete(unsigned* bar, unsigned x, unsigned& nloc, unsigned& nx) {
    const unsigned G = gridDim.x * gridDim.y * gridDim.z;
    unsigned sum, cnt, mine, sp = 0u;
    for (;;) {
        sum = 0u; cnt = 0u; mine = 0u;
#pragma unroll
        for (unsigned j = 0; j < 16; ++j) { const unsigned c = xb_ld(&bar[XB_XCNT(j)]); sum += c; cnt += (c > 0u) ? 1u : 0u; mine = (j == x) ? c : mine; }
        if (sum == G) break;
        __builtin_amdgcn_s_sleep(1);
        if ((++sp & 255u) == 0u) { if (xb_ld(&bar[XB_TMO])) break; if (sp > XB_SPIN_CAP) { atomicAdd(&bar[XB_TMO], 1u); break; } }
    }
    nloc = mine > 0u ? mine : 1u; nx = cnt > 0u ? cnt : 1u;
}

__device__ __forceinline__ void xcd_barrier(const XcdBarrier& b) {
    asm volatile("s_waitcnt vmcnt(0)" ::: "memory");
    __syncthreads();
    if (threadIdx.x == 0) {
        unsigned* bar = b.bar;
        __builtin_amdgcn_s_waitcnt(0);
        unsigned nloc = b.st[0], nx = b.st[1];
        if (nloc == 0u) { xcd_barrier_complete(bar, b.x, nloc, nx); b.st[0] = nloc; b.st[1] = nx; }
        const unsigned old = xb_add(&bar[XB_XSUB(b.x)], 1u);
        const unsigned gen = old / nloc;
        if (old + 1u == (gen + 1u) * nloc) {
            __builtin_amdgcn_fence(__ATOMIC_RELEASE, "agent");
            asm volatile("s_waitcnt vmcnt(0)" ::: "memory");
            const unsigned og = xb_add(&bar[XB_TOP], 1u);
            const unsigned tg = og / nx;
            if (og + 1u == (tg + 1u) * nx) xb_add(&bar[XB_TOPGEN], 1u);
            else XB_SPIN(xb_ld(&bar[XB_TOPGEN]) == tg, bar);
            __builtin_amdgcn_fence(__ATOMIC_ACQUIRE, "agent");
            xb_add(&bar[XB_XGEN(b.x)], 1u);
            asm volatile("s_waitcnt vmcnt(0)" ::: "memory");
        } else {
            XB_SPIN(xb_ld(&bar[XB_XGEN(b.x)]) == gen, bar);
            __builtin_amdgcn_fence(__ATOMIC_ACQUIRE, "agent");
            asm volatile("s_waitcnt vmcnt(0)" ::: "memory");
        }
    }
    __syncthreads();
}
#ifndef MXMASK
#define MXMASK 15
#endif
constexpr int MX_C = 128, MX_A = 512, MX_B = 128, MX_D = 128, MX_ALL = MX_C + MX_A + MX_B + MX_D;
__device__ __forceinline__ void mixer_phase(const Params& p, int l, unsigned char* lds, unsigned* ctr, volatile int* slot, int imask = 15) {
    const bfu* Z = (const bfu*)(p.ws + WS_ACT); bfu* MG = (bfu*)(p.ws + WS_MG);
    const float* qg = p.in[14] + l * 64; const float* kg = p.in[15] + l * 64; const float* sinks = p.in[16] + l * 8;
    const float* convw = p.in[17] + l * 2048; const float* convb = p.in[18] + l * 512;
    const float* wrg = p.in[19] + (size_t)l * 32768; const float* brg = p.in[20] + l * 512; const float* wig = p.in[21] + (size_t)l * 32768; const float* big = p.in[22] + l * 512;
    const float* lam = p.in[23] + l * 512;
    float* out = p.out;
    int cur = wq_next(ctr, slot);
    while (cur < MX_ALL) {
        unsigned pre = 0u;
        if (threadIdx.x == 0) pre = atomicAdd(ctr, 1u);
        int it = cur;
        if (it < MX_C) { if (imask & 1) lru_item<false>(it, Z, nullptr, nullptr, convw, convb, wrg, brg, wig, big, lam, MG, out + O_CP + (size_t)l * 16 * 1536, out + O_LP + (size_t)l * 16 * 512, lds); }
        else if ((it -= MX_C) < MX_A) { if (imask & 2) attn_item(it, Z, qg, kg, sinks, MG, out + O_KP + (size_t)l * 262144, out + O_VP + (size_t)l * 262144, lds); }
        else if ((it -= MX_A) < MX_B) { if (imask & 4) sattn_item(it, Z, p.in[2] + (size_t)l * 2097152, p.in[3] + (size_t)l * 2097152, qg, kg, sinks, MG, out + O_KS + (size_t)l * 2097152, out + O_VS + (size_t)l * 2097152, lds); }
        else { it -= MX_B; if (imask & 8) lru_item<true>(it, Z, p.in[4] + (size_t)l * 128 * 1536, p.in[5] + (size_t)l * 128 * 512, convw, convb, wrg, brg, wig, big, lam, MG, out + O_CS + (size_t)l * 128 * 1536, out + O_LS + (size_t)l * 128 * 512, lds); }
        __syncthreads();
        if (threadIdx.x == 0) *slot = (int)pre;
        __syncthreads();
        cur = *slot;
    }
}

__device__ __forceinline__ void grid_barrier(cg::grid_group& grid) {
    asm volatile("s_waitcnt vmcnt(0) lgkmcnt(0)" ::: "memory");
    __syncthreads();
    grid.sync();
    __builtin_amdgcn_fence(__ATOMIC_ACQUIRE, "agent");
    asm volatile("s_waitcnt vmcnt(0)" ::: "memory");
    __syncthreads();
}
#ifndef PH_HI
#define PH_HI 1000
#endif
#ifndef N_PHASES_CUT
#define N_PHASES_CUT 0
#endif
__global__ void __launch_bounds__(512, 2) fwd_kernel(Params p, int ph_lo, int ph_hi) {
    extern __shared__ __attribute__((aligned(16))) unsigned char lds[];
    cg::grid_group grid = cg::this_grid();
    volatile int* slot = (volatile int*)(lds + 131072);
    PG8_LAS unsigned char* lds3 = (PG8_LAS unsigned char*)lds;
    unsigned* ctl = (unsigned*)(p.ws + WS_CTL);
    const bfu* wsW = (const bfu*)(p.ws + WS_W); const float* mod = (const float*)(p.ws + WS_MOD);
    bfu* H = (bfu*)(p.ws + WS_H); bfu* MG = (bfu*)(p.ws + WS_MG); bfu* ACT = (bfu*)(p.ws + WS_ACT);
    float* X = p.out;
    const int G = gridDim.x, bx = blockIdx.x;
    if (threadIdx.x < 2) ((volatile LAS unsigned*)(lds3 + 131072 + 64))[threadIdx.x] = 0u;
    __syncthreads();
    const XcdBarrier xb = xcd_barrier_post(ctl + 4096, (volatile LAS unsigned*)(lds3 + 131072 + 64));
#define SEAM() do { if (ph_hi < 0) grid_barrier(grid); else xcd_barrier(xb); } while (0)
    int ph = 0;
#ifndef PHMASK
#define PHMASK 0xff
#endif
#ifndef DBG_IMASK
#define DBG_IMASK 1
#endif
#ifndef REPMASK
#define REPMASK 0
#endif
#define PHASE(id, ...) do { if (ph >= ph_lo && ph < ph_hi) { if constexpr ((PHMASK >> id) & 1) { const int nrep_ = ((REPMASK >> id) & 1) ? 2 : 1; \
    for (int rep_ = 0; rep_ < nrep_; ++rep_) { __VA_ARGS__; if (rep_ + 1 < nrep_) SEAM(); } } if (ph + 1 < ph_hi) SEAM(); } ++ph; } while (0)
    PHASE(0, prologue_phase(p, lds, ctl + 512 * rep_, slot));
    PHASE(7, { pg8::Gemm g{(const bfu*)(p.ws + WS_SC), (const bfu*)(p.ws + WS_WADA), 256, 2 * NMODC, 1024}; pg8::StaticOrder S; S.init(256, 2 * NMODC, G, bx);
               pg8::EpiMod E{(float*)(p.ws + WS_MOD), p.in[9]}; pg8::gemm_phase<pg8::EpiMod, pg8::StaticOrder, true, true>(lds3, g, S, E); });
    float* XS = X + (size_t)MP * DM; float* PART = (float*)(p.ws + 404 * MiB);
    bfu* XB = (bfu*)(p.ws + 448 * MiB);
    PHASE(1, norm_phase(p.in[0], p.in[1], mod, 0, 1, H, nullptr, 0, nullptr, nullptr));
    for (int l = 0; l < 2; ++l) {
        const bfu* wl = wsW + (size_t)l * W_LAYER; const float* modl = mod + (size_t)l * NCB * NMODC;
        const float* xP = l == 0 ? p.in[0] : X; const float* xS = l == 0 ? p.in[1] : XS;
        PHASE(2, { pg8::Gemm g{H, wl + W_UP1, MT, 5632, 1024}; pg8::StaticOrder S; S.init(MT, 5632, G, bx); pg8::EpiSwiglu E{ACT, DFF};
                pg8::gemm_phase<pg8::EpiSwiglu, pg8::StaticOrder, true, true>(lds3, g, S, E); });
        if (l == 0) PHASE(3, { pg8::Gemm g{ACT, wl + W_DN1, MT, 1024, DFF}; pg8::SplitOrder S; S.init(1024, DFF, G, bx); pg8::EpiResid<0> E{p.in[0], nullptr, nullptr, XB, modl + 2 * DM, 0.5f, PART};
                pg8::gemm_phase<pg8::EpiResid<0>, pg8::SplitOrder, true, true>(lds3, g, S, E); });
        else PHASE(3, { pg8::Gemm g{ACT, wl + W_DN1, MT, 1024, DFF}; pg8::SplitOrder S; S.init(1024, DFF, G, bx); pg8::EpiResid<1> E{nullptr, XB, nullptr, XB, modl + 2 * DM, 0.5f, PART};
                pg8::gemm_phase<pg8::EpiResid<1>, pg8::SplitOrder, true, true>(lds3, g, S, E); });
        PHASE(1, norm_phase(X, xS, modl, 3, 4, H, PART, DFF / 256, XS, XB));
        PHASE(4, { pg8::Gemm g{H, wl + W_IN, MT, INC, 1024}; pg8::StaticOrder S; S.init(MT, INC, G, bx); pg8::EpiPlainBf16 E{ACT, INC};
                pg8::gemm_phase<pg8::EpiPlainBf16, pg8::StaticOrder, true, true>(lds3, g, S, E); });
        PHASE(5, mixer_phase(p, l, lds, ctl + 64 * (1 + l) + 512 * rep_, slot, rep_ ? DBG_IMASK : 15));
        PHASE(6, mgnorm_phase(MG, MG, p.in[24] + l * 512, p.in[25] + l * 512));
        PHASE(3, { pg8::Gemm g{MG, wl + W_OUT, MT, 1024, 1024}; pg8::SplitOrder S; S.init(1024, 1024, G, bx); pg8::EpiResid<1> E{nullptr, XB, nullptr, XB, modl + 5 * DM, 1.0f, PART};
                pg8::gemm_phase<pg8::EpiResid<1>, pg8::SplitOrder, true, true>(lds3, g, S, E); });
        PHASE(1, norm_phase(X, XS, modl, 6, 7, H, PART, 4, XS, XB));
        PHASE(2, { pg8::Gemm g{H, wl + W_UP2, MT, 5632, 1024}; pg8::StaticOrder S; S.init(MT, 5632, G, bx); pg8::EpiSwiglu E{ACT, DFF};
                pg8::gemm_phase<pg8::EpiSwiglu, pg8::StaticOrder, true, true>(lds3, g, S, E); });
        if (l == 0) PHASE(3, { pg8::Gemm g{ACT, wl + W_DN2, MT, 1024, DFF}; pg8::SplitOrder S; S.init(1024, DFF, G, bx); pg8::EpiResid<1> E{nullptr, XB, nullptr, XB, modl + 8 * DM, 0.5f, PART};
                pg8::gemm_phase<pg8::EpiResid<1>, pg8::SplitOrder, true, true>(lds3, g, S, E); });
        else PHASE(3, { pg8::Gemm g{ACT, wl + W_DN2, MT, 1024, DFF}; pg8::SplitOrder S; S.init(1024, DFF, G, bx); pg8::EpiResid<2> E{nullptr, XB, X, nullptr, modl + 8 * DM, 0.5f, PART};
                pg8::gemm_phase<pg8::EpiResid<2>, pg8::SplitOrder, true, true>(lds3, g, S, E); });
        if (l == 0) PHASE(1, norm_phase(X, XS, mod + (size_t)NCB * NMODC, 0, 1, H, PART, DFF / 256, XS, XB));
        else PHASE(1, fix_phase(XS, PART, DFF / 256));
    }
#undef PHASE
}

extern "C" void kernel_launch(void* const* d_in, const int* in_sizes, int n_in, void* d_out, int out_size, void* d_ws, size_t ws_size, hipStream_t stream) {
    static int grid = 0;
    if (grid == 0) {
        if (n_in != 30 || ws_size < 512 * MiB) { fprintf(stderr, "kernel_launch: unexpected n_in %d / ws %zu\n", n_in, ws_size); grid = -1; return; }
        int dev = 0, cus = 0, per_cu = 0;
        hipGetDevice(&dev); hipDeviceGetAttribute(&cus, hipDeviceAttributeMultiprocessorCount, dev);
        if (hipFuncSetAttribute((const void*)fwd_kernel, hipFuncAttributeMaxDynamicSharedMemorySize, LDS_BYTES) != hipSuccess) { fprintf(stderr, "kernel_launch: hipFuncSetAttribute failed\n"); grid = -1; return; }
        hipOccupancyMaxActiveBlocksPerMultiprocessor(&per_cu, (const void*)fwd_kernel, 512, LDS_BYTES);
        if (per_cu < 1) { fprintf(stderr, "kernel_launch: occupancy query says %d\n", per_cu); per_cu = 1; }
        (void)hipGetLastError();
        grid = cus * 1;
    }
    if (grid < 0) return;
    hipMemsetAsync((char*)d_ws + WS_CTL, 0, 32768, stream);
    Params p{};
    for (int i = 0; i < 30; ++i) p.in[i] = (const float*)d_in[i];
    p.out = (float*)d_out; p.ws = (unsigned char*)d_ws;
    int lo = 0, hi = PH_HI;
    void* args[] = {&p, &lo, &hi};
    hipError_t e = hipLaunchCooperativeKernel((const void*)fwd_kernel, dim3(grid), dim3(512), args, LDS_BYTES, stream);
    if (e != hipSuccess) fprintf(stderr, "cooperative launch failed: %s (grid %d)\n", hipGetErrorString(e), grid);
}
```

```cpp
#include <hip/hip_runtime.h>
#include <hip/hip_cooperative_groups.h>
#include <cstdio>
#include <cstdint>
namespace cg = cooperative_groups;
namespace pg8 {
#define PG8_LAS __attribute__((address_space(3)))
typedef unsigned short bf16_t;
typedef short bf16x8 __attribute__((ext_vector_type(8)));
typedef float f32x4 __attribute__((ext_vector_type(4)));
typedef unsigned u32x4 __attribute__((ext_vector_type(4)));
typedef unsigned u32x2 __attribute__((ext_vector_type(2)));
constexpr int BM = 256, BK = 64, HALF = 128, HTB = HALF * BK * 2  , STAGE_BYTES = 8 * HTB, NXCD = 8, WGM = 8;

__host__ __device__ __forceinline__ int lds_byte(int r, int c) { const int st = (r >> 4) * 2 + (c >> 5), rr = r & 15, cc = c & 31, ob = rr * 64 + cc * 2; return st * 1024 + (ob ^ (((ob >> 9) & 1) << 5)); }
__host__ __device__ __forceinline__ void stage_rc(int b, int& R, int& C) { const int st = b / 1024, sb = b % 1024, swz = sb ^ (((sb >> 9) & 1) << 5); R = (st >> 1) * 16 + swz / 64; C = (st & 1) * 32 + (swz % 64) / 2; }
__host__ __device__ __forceinline__ int perm32(int rho) { const int n = rho >> 4, i = rho & 15; return 8 * (i >> 2) + 4 * n + (i & 3); }

struct Unit { int pm, pn, k0, nt; };
struct Gemm { const bf16_t* A; const bf16_t* Bt; int M, N, K; };

struct StaticOrder {
    int nM, nN, nwg, G, c;
    __host__ __device__ void init(int M, int N, int G_, int c_) { nM = M / BM; nN = N / BM; nwg = nM * nN; G = G_; c = c_; }
    __host__ __device__ bool next(int i, Unit& u) const {
        const long L = (long)i * G + c; if (L >= nwg) return false;
        int wgid = (int)L; { const int q = nwg / NXCD, r = nwg % NXCD, xcd = wgid % NXCD, off = wgid / NXCD; wgid = (xcd < r ? xcd * (q + 1) : r * (q + 1) + (xcd - r) * q) + off; }
        const int nig = WGM * nN, gid = wgid / nig, fm = gid * WGM, gsz = (nM - fm) < WGM ? (nM - fm) : WGM;
        u.pm = fm + ((wgid % nig) % gsz); u.pn = (wgid % nig) / gsz; u.k0 = 0; u.nt = 0; return true;
    }
    __device__ __forceinline__ void a_ready(const Unit&) const {}
    __device__ __forceinline__ void done(const Unit&) const {}
};
struct SplitOrder {
    StaticOrder so; int nfull, nch, nN, G, c;
    __host__ __device__ void init(int N, int K, int G_, int c_) { so.init(128 * BM, N, G_, c_); nN = N / BM; nfull = 128 * nN; nch = K / 256; G = G_; c = c_; }
    __host__ __device__ bool next(int i, Unit& u) const {
        const long L = (long)i * G + c;
        if (L < nfull) { const int nr = nfull / G; return so.next((nr * G == nfull && i < nr) ? nr - 1 - i : i, u); }
        const int j = (int)(L - nfull); if (j >= 4 * nN * nch) return false;
        const int ch = j / (4 * nN), rem = j % (4 * nN);
        u.pm = 128 + rem / nN; u.pn = rem % nN; u.k0 = 4 * ch; u.nt = 4; return true;
    }
    __device__ __forceinline__ void a_ready(const Unit&) const {}
    __device__ __forceinline__ void done(const Unit&) const {}
};


__device__ __forceinline__ unsigned cvt_pk_bf16(float lo, float hi) { unsigned r; asm volatile("v_cvt_pk_bf16_f32 %0, %1, %2" : "=v"(r) : "v"(lo), "v"(hi)); return r; }
typedef float f32x2 __attribute__((ext_vector_type(2)));
constexpr int MP_ROWS = 32768;
#ifndef RESID_GB
#define RESID_GB 4
#endif
struct EpiSwiglu {
    static constexpr bool PERM = true, AFTER_DRAIN = false;
    bf16_t* O; int ldc;
    __device__ __forceinline__ void operator()(const f32x4 (&acc)[2][2][4][2], const Unit& u, int wr, int wc, int fr, int fq) const {
        const int row0 = u.pm * BM + wr * 64 + fr, col0 = u.pn * 128 + wc * 32 + 8 * fq;
#pragma unroll
        for (int ai = 0; ai < 2; ++ai)
#pragma unroll
            for (int m = 0; m < 4; ++m) {
                bf16_t* p = O + (size_t)(row0 + ai * HALF + m * 16) * ldc + col0;
                float v[8];
#pragma unroll
                for (int n = 0; n < 2; ++n)
#pragma unroll
                    for (int e = 0; e < 4; ++e) { const float g = acc[ai][0][m][n][e], up = acc[ai][1][m][n][e];
                        v[n * 4 + e] = g * up * __builtin_amdgcn_rcpf(1.f + __expf(-g)); }
                u32x4 w; w.x = cvt_pk_bf16(v[0], v[1]); w.y = cvt_pk_bf16(v[2], v[3]); w.z = cvt_pk_bf16(v[4], v[5]); w.w = cvt_pk_bf16(v[6], v[7]);
                *(u32x4*)p = w;
            }
    }
};
struct EpiPlainBf16 {
    static constexpr bool PERM = true, AFTER_DRAIN = false;
    bf16_t* O; int ldc;
    __device__ __forceinline__ void operator()(const f32x4 (&acc)[2][2][4][2], const Unit& u, int wr, int wc, int fr, int fq) const {
        const int row0 = u.pm * BM + wr * 64 + fr, col0 = u.pn * BM + wc * 32 + 8 * fq;
#pragma unroll
        for (int ai = 0; ai < 2; ++ai)
#pragma unroll
            for (int m = 0; m < 4; ++m) {
                bf16_t* p = O + (size_t)(row0 + ai * HALF + m * 16) * ldc + col0;
#pragma unroll
                for (int bj = 0; bj < 2; ++bj) { const f32x4 v0 = acc[ai][bj][m][0], v1 = acc[ai][bj][m][1];
                    u32x4 w; w.x = cvt_pk_bf16(v0[0], v0[1]); w.y = cvt_pk_bf16(v0[2], v0[3]); w.z = cvt_pk_bf16(v1[0], v1[1]); w.w = cvt_pk_bf16(v1[2], v1[3]);
                    *(u32x4*)(p + bj * HALF) = w; }
            }
    }
};
template <int MODE> struct EpiResid {
    static constexpr bool PERM = true, AFTER_DRAIN = false;
    const float* resF; const bf16_t* resB; float* outF; bf16_t* outB; const float* gate; float coef; float* part;
    __device__ __forceinline__ void operator()(const f32x4 (&acc)[2][2][4][2], const Unit& u, int wr, int wc, int fr, int fq) const {
        const int row0 = u.pm * BM + wr * 64 + fr, col0 = u.pn * BM + wc * 32 + 8 * fq;
        if (u.nt != 0) {
            float* pb = part + (size_t)(u.k0 >> 2) * 1024 * 1024;
#pragma unroll
            for (int aim = 0; aim < 4; ++aim) { const int ai = aim >> 1, m0 = (aim & 1) * 2;
                f32x4 g[4][2][2];
#pragma unroll
                for (int m = m0; m < m0 + 2; ++m) { const int row = row0 + ai * HALF + m * 16 - MP_ROWS; const float* gp = gate + (size_t)(16 + (row >> 3)) * 9216 + col0;
#pragma unroll
                    for (int bj = 0; bj < 2; ++bj)
#pragma unroll
                        for (int n = 0; n < 2; ++n) g[m][bj][n] = *(const f32x4*)(gp + bj * HALF + n * 4); }
                asm volatile("" ::: "memory");
#pragma unroll
                for (int m = m0; m < m0 + 2; ++m) { const int row = row0 + ai * HALF + m * 16 - MP_ROWS; float* op = pb + (size_t)row * 1024 + col0;
#pragma unroll
                    for (int bj = 0; bj < 2; ++bj)
#pragma unroll
                        for (int n = 0; n < 2; ++n) *(f32x4*)(op + bj * HALF + n * 4) = (g[m][bj][n] * coef) * acc[ai][bj][m][n]; }
                asm volatile("" ::: "memory");
            }
            return;
        }
        const float* gp = gate + (size_t)(u.pm >> 3) * 9216 + col0;
        f32x4 gc[2][2];
#pragma unroll
        for (int bj = 0; bj < 2; ++bj)
#pragma unroll
            for (int n = 0; n < 2; ++n) gc[bj][n] = *(const f32x4*)(gp + bj * HALF + n * 4);
        asm volatile("" ::: "memory");
#pragma unroll
        for (int bj = 0; bj < 2; ++bj)
#pragma unroll
            for (int n = 0; n < 2; ++n) gc[bj][n] = gc[bj][n] * coef;
        constexpr int GB = (MODE == 0) ? 2 : RESID_GB;
#pragma unroll
        for (int g0 = 0; g0 < 8; g0 += GB) {
            f32x4 r[8][2][2]; u32x4 rb[8][2];
#pragma unroll
            for (int gi = g0; gi < g0 + GB; ++gi) { const int ai = gi >> 2, m = gi & 3; const size_t off = (size_t)(row0 + ai * HALF + m * 16) * 1024 + col0;
#pragma unroll
                for (int bj = 0; bj < 2; ++bj) {
                    if (MODE == 0) { r[gi][bj][0] = *(const f32x4*)(resF + off + bj * HALF); r[gi][bj][1] = *(const f32x4*)(resF + off + bj * HALF + 4); }
                    else rb[gi][bj] = *(const u32x4*)(resB + off + bj * HALF); } }
            asm volatile("" ::: "memory");
#pragma unroll
            for (int gi = g0; gi < g0 + GB; ++gi) { const int ai = gi >> 2, m = gi & 3; const size_t off = (size_t)(row0 + ai * HALF + m * 16) * 1024 + col0;
#pragma unroll
                for (int bj = 0; bj < 2; ++bj) {
                    f32x4 x0, x1;
                    if (MODE == 0) { x0 = r[gi][bj][0]; x1 = r[gi][bj][1]; }
                    else { const u32x4 w = rb[gi][bj];
                        x0 = (f32x4){__uint_as_float(w.x << 16), __uint_as_float(w.x & 0xffff0000u), __uint_as_float(w.y << 16), __uint_as_float(w.y & 0xffff0000u)};
                        x1 = (f32x4){__uint_as_float(w.z << 16), __uint_as_float(w.z & 0xffff0000u), __uint_as_float(w.w << 16), __uint_as_float(w.w & 0xffff0000u)}; }
                    const f32x4 o0 = x0 + gc[bj][0] * acc[ai][bj][m][0], o1 = x1 + gc[bj][1] * acc[ai][bj][m][1];
                    if (MODE == 2) { *(f32x4*)(outF + off + bj * HALF) = o0; *(f32x4*)(outF + off + bj * HALF + 4) = o1; }
                    else { u32x4 w; w.x = cvt_pk_bf16(o0[0], o0[1]); w.y = cvt_pk_bf16(o0[2], o0[3]); w.z = cvt_pk_bf16(o1[0], o1[1]); w.w = cvt_pk_bf16(o1[2], o1[3]); *(u32x4*)(outB + off + bj * HALF) = w; } } }
            asm volatile("" ::: "memory");
        }
    }
};
struct EpiMod {
    static constexpr bool PERM = false, AFTER_DRAIN = false;
    float* mod; const float* bada;
    __device__ __forceinline__ void operator()(const f32x4 (&acc)[2][2][4][2], const Unit& u, int wr, int wc, int fr, int fq) const {
        const int row0 = wr * 64 + fr, n0 = u.pn * BM + wc * 32 + 4 * fq, l = n0 / 9216, j0 = n0 - l * 9216;
        f32x4 bv[2][2];
#pragma unroll
        for (int bj = 0; bj < 2; ++bj)
#pragma unroll
            for (int n = 0; n < 2; ++n) bv[bj][n] = *(const f32x4*)(bada + (size_t)l * 9216 + j0 + bj * HALF + n * 16);
        asm volatile("" ::: "memory");
#pragma unroll
        for (int ai = 0; ai < 2; ++ai)
#pragma unroll
            for (int m = 0; m < 4; ++m) {
                const int row = row0 + ai * HALF + m * 16;
                if (row < 144) {
                    float* op = mod + ((size_t)l * 144 + row) * 9216 + j0;
#pragma unroll
                    for (int bj = 0; bj < 2; ++bj)
#pragma unroll
                        for (int n = 0; n < 2; ++n) { const int c = bj * HALF + n * 16; *(f32x4*)(op + c) = acc[ai][bj][m][n] + bv[bj][n]; }
                }
            }
    }
};
template <class Epi, class Sched, bool ALIGN_EPI = false, bool SP2 = false>
__device__ __forceinline__ void gemm_phase(PG8_LAS unsigned char* lds, const Gemm g, const Sched& S, const Epi& E) {
    int tid_ = threadIdx.x; asm volatile("" : "+v"(tid_));
    const int tid = tid_, wid = __builtin_amdgcn_readfirstlane(tid >> 6), lane = tid & 63, wr = wid >> 2, wc = wid & 3, fr = lane & 15, fq = lane >> 4;
    const int K = g.K, ntf = K / BK;
    unsigned voffA[2], voffB[2];
#pragma unroll
    for (int i = 0; i < 2; ++i) { int R, C; stage_rc(tid * 16 + i * 8192, R, C); const int Rb = Epi::PERM ? ((R & ~31) + perm32(R & 31)) : R;
        voffA[i] = (unsigned)(R * K + C) * 2u; voffB[i] = (unsigned)(Rb * K + C) * 2u; }
    const size_t kstep = (size_t)(BK * 2);
    const size_t hstep = (size_t)HALF * K * 2;
    const size_t tstep = 2 * hstep;
    const unsigned ldsw = (unsigned)wid * 1024u;
    const int aoff = lds_byte(wr * 64 + fr, fq * 8), boff = lds_byte(wc * 32 + fr, fq * 8);
#define PG8_SA(b, h) (((b) * 2 + (h)) * HTB)
#define PG8_SB(b, h) ((4 + (b) * 2 + (h)) * HTB)
#define PG8_STAGE(bufoff, gbase, voff) do { _Pragma("unroll") for (int _i = 0; _i < 2; ++_i) \
        __builtin_amdgcn_global_load_lds((const unsigned*)((const char*)(gbase) + (voff)[_i]), (PG8_LAS unsigned*)(lds + (bufoff) + ldsw + _i * 8192), 16, 0, 0); } while (0)
#define PG8_LDA(dst, b, h) do { _Pragma("unroll") for (int m = 0; m < 4; ++m) _Pragma("unroll") for (int k = 0; k < 2; ++k) dst[m][k] = *(const PG8_LAS bf16x8*)(lds + PG8_SA(b, h) + aoff + m * 2048 + k * 1024); } while (0)
#define PG8_LDB(dst, b, h) do { _Pragma("unroll") for (int n = 0; n < 2; ++n) _Pragma("unroll") for (int k = 0; k < 2; ++k) dst[n][k] = *(const PG8_LAS bf16x8*)(lds + PG8_SB(b, h) + boff + n * 2048 + k * 1024); } while (0)
#define PG8_MMA(ai, bj, At, Bt) do { __builtin_amdgcn_s_setprio(1); _Pragma("unroll") for (int m = 0; m < 4; ++m) _Pragma("unroll") for (int n = 0; n < 2; ++n) _Pragma("unroll") for (int k = 0; k < 2; ++k) \
        acc[ai][bj][m][n] = __builtin_amdgcn_mfma_f32_16x16x32_bf16(Bt[n][k], At[m][k], acc[ai][bj][m][n], 0, 0, 0); __builtin_amdgcn_s_setprio(0); } while (0)
#define PG8_WAIT_V(n) asm volatile("s_waitcnt vmcnt(" #n ")" ::: "memory")
#define PG8_WAIT_L(n) asm volatile("s_waitcnt lgkmcnt(" #n ")" ::: "memory")
#define PG8_BAR __builtin_amdgcn_s_barrier()
#define PG8_SCHED __builtin_amdgcn_sched_barrier(0)
    Unit cur, nxt; int ui = 0;
    if (!S.next(0, cur)) return;
    f32x4 acc[2][2][4][2];
#pragma unroll
    for (int a = 0; a < 2; ++a)
#pragma unroll
        for (int b = 0; b < 2; ++b)
#pragma unroll
            for (int m = 0; m < 4; ++m)
#pragma unroll
                for (int n = 0; n < 2; ++n) acc[a][b][m][n] = (f32x4){0.f, 0.f, 0.f, 0.f};
    bf16x8 At[4][2], B0[2][2], B1[2][2];
    int nt = cur.nt ? cur.nt : ntf;
    const char* cA = (const char*)g.A + (size_t)cur.pm * tstep + (size_t)cur.k0 * kstep; const char* cB = (const char*)g.Bt + (size_t)cur.pn * tstep + (size_t)cur.k0 * kstep;
    S.a_ready(cur);
    if constexpr (SP2) {
        PG8_STAGE(PG8_SB(0, 0), cB, voffB); PG8_STAGE(PG8_SB(0, 1), cB + hstep, voffB); PG8_STAGE(PG8_SA(0, 0), cA, voffA); PG8_STAGE(PG8_SA(0, 1), cA + hstep, voffA);
        if (wr == 1) PG8_BAR;
        PG8_WAIT_V(2); PG8_BAR;
        PG8_STAGE(PG8_SB(1, 0), cB + kstep, voffB); PG8_STAGE(PG8_SA(1, 0), cA + kstep, voffA); PG8_STAGE(PG8_SB(1, 1), cB + hstep + kstep, voffB);
        PG8_WAIT_V(6); PG8_BAR;
    } else {
        PG8_STAGE(PG8_SB(0, 0), cB, voffB); PG8_STAGE(PG8_SA(0, 0), cA, voffA); PG8_STAGE(PG8_SB(0, 1), cB + hstep, voffB); PG8_STAGE(PG8_SA(0, 1), cA + hstep, voffA);
        if (wr == 1) PG8_BAR;
        PG8_WAIT_V(4); PG8_BAR;
        PG8_STAGE(PG8_SB(1, 0), cB + kstep, voffB); PG8_STAGE(PG8_SA(1, 0), cA + kstep, voffA); PG8_STAGE(PG8_SB(1, 1), cB + hstep + kstep, voffB);
        PG8_WAIT_V(6); PG8_BAR;
    }
    for (;;) {
        const bool has_next = S.next(ui + 1, nxt);
        const char* nA = has_next ? (const char*)g.A + (size_t)nxt.pm * tstep + (size_t)nxt.k0 * kstep : cA; const char* nB = has_next ? (const char*)g.Bt + (size_t)nxt.pn * tstep + (size_t)nxt.k0 * kstep : cB;
        for (int t = 0; t < nt; t += 2) {
            const bool last = (t == nt - 2);
            const char* a1 = cA + (size_t)(t + 1) * kstep;
            const char* a2 = last ? nA : cA + (size_t)(t + 2) * kstep; const char* b2 = last ? nB : cB + (size_t)(t + 2) * kstep;
            const char* a3 = a2 + kstep; const char* b3 = b2 + kstep;
            if (last && has_next) S.a_ready(nxt);
            if constexpr (SP2) {
            PG8_LDB(B0, 0, 0); PG8_LDB(B1, 0, 1); PG8_SCHED; PG8_LDA(At, 0, 0); PG8_STAGE(PG8_SA(1, 1), a1 + hstep, voffA);
            PG8_WAIT_V(8); PG8_WAIT_L(0); PG8_BAR; PG8_MMA(0, 0, At, B0); PG8_MMA(0, 1, At, B1); PG8_BAR; PG8_SCHED;
            PG8_LDA(At, 0, 1); PG8_STAGE(PG8_SB(0, 0), b2, voffB); PG8_STAGE(PG8_SB(0, 1), b2 + hstep, voffB); PG8_STAGE(PG8_SA(0, 0), a2, voffA);
            PG8_WAIT_V(8); PG8_WAIT_L(0); PG8_BAR; PG8_MMA(1, 0, At, B0); PG8_MMA(1, 1, At, B1); PG8_BAR; PG8_SCHED;
            PG8_LDB(B0, 1, 0); PG8_LDB(B1, 1, 1); PG8_SCHED; PG8_LDA(At, 1, 0); PG8_STAGE(PG8_SA(0, 1), a2 + hstep, voffA);
            PG8_WAIT_V(8); PG8_WAIT_L(0); PG8_BAR; PG8_MMA(0, 0, At, B0); PG8_MMA(0, 1, At, B1); PG8_BAR; PG8_SCHED;
            PG8_LDA(At, 1, 1); PG8_STAGE(PG8_SB(1, 0), b3, voffB); PG8_STAGE(PG8_SB(1, 1), b3 + hstep, voffB); PG8_STAGE(PG8_SA(1, 0), a3, voffA);
            PG8_WAIT_V(8); PG8_WAIT_L(0); PG8_BAR; PG8_MMA(1, 0, At, B0); PG8_MMA(1, 1, At, B1); PG8_BAR; PG8_SCHED;
            } else {
            PG8_LDB(B0, 0, 0); PG8_SCHED; PG8_LDA(At, 0, 0); PG8_STAGE(PG8_SA(1, 1), a1 + hstep, voffA);
            PG8_WAIT_L(8); PG8_BAR; PG8_WAIT_L(0); PG8_MMA(0, 0, At, B0); PG8_BAR; PG8_SCHED;
            PG8_LDB(B1, 0, 1); PG8_STAGE(PG8_SB(0, 0), b2, voffB);
            PG8_BAR; PG8_WAIT_L(0); PG8_MMA(0, 1, At, B1); PG8_BAR;
            PG8_LDA(At, 0, 1); PG8_STAGE(PG8_SA(0, 0), a2, voffA);
            PG8_BAR; PG8_WAIT_L(0); PG8_MMA(1, 0, At, B0); PG8_BAR; PG8_SCHED;
            PG8_STAGE(PG8_SB(0, 1), b2 + hstep, voffB);
            PG8_WAIT_V(6); PG8_BAR; PG8_MMA(1, 1, At, B1); PG8_BAR;
            PG8_LDB(B0, 1, 0); PG8_SCHED; PG8_LDA(At, 1, 0); PG8_STAGE(PG8_SA(0, 1), a2 + hstep, voffA);
            PG8_WAIT_L(8); PG8_BAR; PG8_WAIT_L(0); PG8_MMA(0, 0, At, B0); PG8_BAR; PG8_SCHED;
            PG8_LDB(B1, 1, 1); PG8_STAGE(PG8_SB(1, 0), b3, voffB);
            PG8_BAR; PG8_WAIT_L(0); PG8_MMA(0, 1, At, B1); PG8_BAR;
            PG8_LDA(At, 1, 1); PG8_STAGE(PG8_SA(1, 0), a3, voffA);
            PG8_BAR; PG8_WAIT_L(0); PG8_MMA(1, 0, At, B0); PG8_BAR; PG8_SCHED;
            PG8_STAGE(PG8_SB(1, 1), b3 + hstep, voffB);
            PG8_WAIT_V(6); PG8_BAR; PG8_MMA(1, 1, At, B1); PG8_BAR;
            }
        }
        if constexpr (ALIGN_EPI) { if (wr == 0) PG8_BAR; }
        if constexpr (!Epi::AFTER_DRAIN) { E(acc, cur, wr, wc, fr, fq); S.done(cur); }
        if (!has_next) break;
#pragma unroll
        for (int a = 0; a < 2; ++a)
#pragma unroll
            for (int b = 0; b < 2; ++b)
#pragma unroll
                for (int m = 0; m < 4; ++m)
#pragma unroll
                    for (int n = 0; n < 2; ++n) acc[a][b][m][n] = (f32x4){0.f, 0.f, 0.f, 0.f};
        cur = nxt; cA = nA; cB = nB; ++ui; nt = cur.nt ? cur.nt : ntf;
        if constexpr (ALIGN_EPI) { if (wr == 1) PG8_BAR; }
    }
    PG8_WAIT_V(0);
    if constexpr (!ALIGN_EPI) { if (wr == 0) PG8_BAR; }
    PG8_BAR;
    if constexpr (Epi::AFTER_DRAIN) { E.fused(acc, cur, wr, wc, fr, fq, lds, wid, lane); S.done(cur); }
#undef PG8_SA
#undef PG8_SB
#undef PG8_STAGE
#undef PG8_LDA
#undef PG8_LDB
#undef PG8_MMA
#undef PG8_WAIT_V
#undef PG8_WAIT_L
#undef PG8_BAR
#undef PG8_SCHED
}
}
typedef unsigned short bfu;
typedef short s16x8 __attribute__((ext_vector_type(8)));
typedef float f4 __attribute__((ext_vector_type(4)));
typedef float f16v __attribute__((ext_vector_type(16)));
typedef unsigned u4 __attribute__((ext_vector_type(4)));
typedef unsigned u2 __attribute__((ext_vector_type(2)));
#define LAS3 __attribute__((address_space(3)))

constexpr int DM = 1024, MP = 32768, MS = 1024, MT = MP + MS, DFF = 2816, INC = 1792, NMODC = 9216, NCB = 144;
constexpr size_t MiB = 1u << 20;
constexpr size_t WS_CTL = 0, WS_MOD = 1 * MiB, WS_W = 12 * MiB, WS_H = 90 * MiB, WS_MG = 156 * MiB, WS_ACT = 222 * MiB, WS_END = 404 * MiB;
constexpr size_t W_UP1 = 0, W_DN1 = W_UP1 + (size_t)5632 * 1024, W_IN = W_DN1 + (size_t)1024 * 2816, W_OUT = W_IN + (size_t)1792 * 1024,
                 W_UP2 = W_OUT + (size_t)1024 * 1024, W_DN2 = W_UP2 + (size_t)5632 * 1024, W_LAYER = W_DN2 + (size_t)1024 * 2816;
static_assert(WS_W + 2 * W_LAYER * 2 <= WS_H, "weights fit");
constexpr size_t O_YP = 0, O_YS = 33554432, O_KP = 34603008, O_VP = O_KP + 524288, O_CP = O_VP + 524288, O_LP = O_CP + 49152, O_KS = O_LP + 16384,
                 O_VS = O_KS + 4194304, O_CS = O_VS + 4194304, O_LS = O_CS + 393216;
constexpr int LDS_BYTES = 131072 + 256;

typedef float f32x2_t __attribute__((ext_vector_type(2))); typedef __bf16 bf16x2_t __attribute__((ext_vector_type(2)));
__device__ __forceinline__ unsigned pkbf(float lo, float hi) { f32x2_t v = {lo, hi}; bf16x2_t b = __builtin_convertvector(v, bf16x2_t); return __builtin_bit_cast(unsigned, b); }
__device__ __forceinline__ float bflo(unsigned w) { return __uint_as_float(w << 16); }
__device__ __forceinline__ float bfhi(unsigned w) { return __uint_as_float(w & 0xffff0000u); }
__device__ __forceinline__ float bf1(bfu b) { return __uint_as_float(((unsigned)b) << 16); }
__device__ __forceinline__ bfu tobf(float f) { return (bfu)(pkbf(f, 0.f) & 0xffffu); }
__device__ __forceinline__ float sigm(float x) { return __builtin_amdgcn_rcpf(1.f + __expf(-x)); }
__device__ __forceinline__ float gelu_tanh(float x) { const float t = 0.7978845608028654f * (x + 0.044715f * x * x * x); return x * sigm(2.f * t); }
__device__ __forceinline__ int crow(int r, int hi) { return (r & 3) + 8 * (r >> 2) + 4 * hi; }

struct Params { const float* in[30]; float* out; unsigned char* ws; };

__device__ __forceinline__ int wq_next(unsigned* ctr, volatile int* slot) {
    __syncthreads();
    if (threadIdx.x == 0) *slot = (int)atomicAdd(ctr, 1u);
    __syncthreads();
    return *slot;
}

__device__ __forceinline__ void transpose_item(const float* W, int K, int N, bfu* WT, int mode, float* scr, int item, int lane) {
    const int nblk = N / 32, kb = item / nblk, nb = item % nblk, k0 = 64 * kb, n0 = 32 * nb;
    const int r0 = mode == 0 ? n0 : ((n0 >> 7) * 256 + (n0 & 127) + (mode == 2 ? 128 : 0));
    float wv[32];
#pragma unroll
    for (int i = 0; i < 32; ++i) { const int kk = 2 * i + (lane >> 5); wv[i] = __builtin_nontemporal_load(W + (size_t)(k0 + kk) * N + n0 + (lane & 31)); }
#pragma unroll
    for (int i = 0; i < 32; ++i) { const int kk = 2 * i + (lane >> 5); scr[kk * 33 + (lane & 31)] = wv[i]; }
    asm volatile("s_waitcnt lgkmcnt(0)" ::: "memory");
    const int c = lane & 7;
#pragma unroll
    for (int jj = 0; jj < 4; ++jj) { const int n = (lane >> 3) + 8 * jj; const float* s = scr + (8 * c) * 33 + n;
        u4 o; o.x = pkbf(s[0], s[33]); o.y = pkbf(s[66], s[99]); o.z = pkbf(s[132], s[165]); o.w = pkbf(s[198], s[231]);
        *(u4*)(WT + (size_t)(r0 + n) * K + k0 + 8 * c) = o; }
    asm volatile("s_waitcnt lgkmcnt(0)" ::: "memory");
}
constexpr int TI_BIG = 1408, TI_IN = 896, TI_OUT = 512, TI_ADA = 4608, TI_LAYER = 6 * TI_BIG + TI_IN + TI_OUT + TI_ADA;
constexpr int N_SC_ITEMS = 8, N_TR_WG_ITEMS = 2 * TI_LAYER / 8;
constexpr size_t WS_WADA = 404 * MiB, WS_SC = 440 * MiB;
__device__ __forceinline__ void prologue_phase(const Params& p, unsigned char* lds, unsigned* ctr, volatile int* slot) {
    int tid_ = threadIdx.x; asm volatile("" : "+v"(tid_));
    const int tid = tid_, lane = tid & 63, w = tid >> 6;
    bfu* wsW = (bfu*)(p.ws + WS_W); bfu* wada = (bfu*)(p.ws + WS_WADA); bfu* SC = (bfu*)(p.ws + WS_SC);
    for (;;) {
        const int it = wq_next(ctr, slot);
        if (it >= N_SC_ITEMS + N_TR_WG_ITEMS) break;
        if (it < N_SC_ITEMS) {
            const int row = it * 32 + (tid >> 4), c0 = (tid & 15) * 64;
            const float* src = row < 16 ? p.in[6] + (size_t)row * 1024 : (row < 144 ? p.in[7] + (size_t)(row - 16) * 1024 : nullptr);
#pragma unroll
            for (int e = 0; e < 16; ++e) { f4 c = src ? *(const f4*)(src + c0 + 4 * e) : (f4){0.f, 0.f, 0.f, 0.f};
                u2 o; o.x = pkbf(c.x * sigm(c.x), c.y * sigm(c.y)); o.y = pkbf(c.z * sigm(c.z), c.w * sigm(c.w));
                *(u2*)(SC + (size_t)row * 1024 + c0 + 4 * e) = o; }
            continue; }
        int wi = (it - N_SC_ITEMS) * 8 + w; const int l = wi / TI_LAYER; int r = wi % TI_LAYER;
        bfu* wl = wsW + (size_t)l * W_LAYER; float* scr = (float*)lds + w * (64 * 33);
        if (r < TI_ADA) { transpose_item(p.in[8] + (size_t)l * 1024 * NMODC, 1024, NMODC, wada + (size_t)l * NMODC * 1024, 0, scr, r, lane); continue; } r -= TI_ADA;
        if (r < TI_BIG) { transpose_item(p.in[10] + (size_t)l * 1024 * DFF, 1024, DFF, wl + W_UP1, 1, scr, r, lane); continue; } r -= TI_BIG;
        if (r < TI_BIG) { transpose_item(p.in[11] + (size_t)l * 1024 * DFF, 1024, DFF, wl + W_UP1, 2, scr, r, lane); continue; } r -= TI_BIG;
        if (r < TI_BIG) { transpose_item(p.in[12] + (size_t)l * DFF * 1024, DFF, 1024, wl + W_DN1, 0, scr, r, lane); continue; } r -= TI_BIG;
        if (r < TI_IN) { transpose_item(p.in[13] + (size_t)l * 1024 * INC, 1024, INC, wl + W_IN, 0, scr, r, lane); continue; } r -= TI_IN;
        if (r < TI_OUT) { transpose_item(p.in[26] + (size_t)l * 1024 * 1024, 1024, 1024, wl + W_OUT, 0, scr, r, lane); continue; } r -= TI_OUT;
        if (r < TI_BIG) { transpose_item(p.in[27] + (size_t)l * 1024 * DFF, 1024, DFF, wl + W_UP2, 1, scr, r, lane); continue; } r -= TI_BIG;
        if (r < TI_BIG) { transpose_item(p.in[28] + (size_t)l * 1024 * DFF, 1024, DFF, wl + W_UP2, 2, scr, r, lane); continue; } r -= TI_BIG;
        transpose_item(p.in[29] + (size_t)l * DFF * 1024, DFF, 1024, wl + W_DN2, 0, scr, r, lane);
    }
}

__device__ __forceinline__ float wave_sum(float v) {
#pragma unroll
    for (int o = 1; o < 64; o <<= 1) v += __shfl_xor(v, o);
    return v;
}
__device__ __forceinline__ void norm_phase(const float* xP, const float* xS, const float* modl, int shi, int sci, bfu* H, const float* part, int nch, float* XSout, const bfu* XbP) {
    int tid_ = threadIdx.x; asm volatile("" : "+v"(tid_));
    const int lane = tid_ & 63, gw = blockIdx.x * 8 + (tid_ >> 6), NGW = gridDim.x * 8;
    f4 v[4], sh[4], sc[4];
#define FI(j) (2 * lane + ((j) & 1) + 128 * ((j) >> 1))
    auto ld = [&](int row, f4 (&vv)[4], f4 (&shh)[4], f4 (&scc)[4]) {
        const bool pr = row < MP;
        const f4* xr = (const f4*)(pr ? xP + (size_t)row * DM : xS + (size_t)(row - MP) * DM);
        const int cb = pr ? (row >> 11) : 16 + ((row - MP) >> 3);
        const f4* shp = (const f4*)(modl + (size_t)cb * NMODC + shi * DM); const f4* scp = (const f4*)(modl + (size_t)cb * NMODC + sci * DM);
#pragma unroll
        for (int j = 0; j < 4; ++j) { shh[j] = shp[FI(j)]; scc[j] = scp[FI(j)]; }
        if (XbP != nullptr && pr) {
            const u4* hr = (const u4*)(XbP + (size_t)row * DM) + lane;
#pragma unroll
            for (int jj = 0; jj < 2; ++jj) { const u4 w = __builtin_nontemporal_load(hr + 64 * jj);
                vv[2 * jj] = (f4){bflo(w.x), bfhi(w.x), bflo(w.y), bfhi(w.y)}; vv[2 * jj + 1] = (f4){bflo(w.z), bfhi(w.z), bflo(w.w), bfhi(w.w)}; }
        } else {
#pragma unroll
            for (int j = 0; j < 4; ++j) vv[j] = __builtin_nontemporal_load(xr + FI(j));
        }
    };
    if (gw < MT) ld(gw, v, sh, sc);
    for (int row = gw; row < MT; row += NGW) {
        f4 vn[4], shn[4], scn[4];
        const int nrow = row + NGW;
        if (nrow < MT) ld(nrow, vn, shn, scn);
        if (nch > 0 && row >= MP) {
            const f4* pp = (const f4*)(part + (size_t)(row - MP) * DM);
            for (int ch = 0; ch < nch; ch += 4) {
                f4 t[4][4];
#pragma unroll
                for (int c2 = 0; c2 < 4; ++c2)
#pragma unroll
                    for (int j = 0; j < 4; ++j) t[c2][j] = (ch + c2 < nch) ? pp[(size_t)(ch + c2) * (1024 * 1024 / 4) + FI(j)] : (f4){0.f, 0.f, 0.f, 0.f};
#pragma unroll
                for (int c2 = 0; c2 < 4; ++c2)
#pragma unroll
                    for (int j = 0; j < 4; ++j) v[j] += t[c2][j];
            }
            f4* xo = (f4*)(XSout + (size_t)(row - MP) * DM);
#pragma unroll
            for (int j = 0; j < 4; ++j) xo[FI(j)] = v[j];
        }
        float s = 0.f;
#pragma unroll
        for (int j = 0; j < 4; ++j) s += (v[j].x * v[j].x + v[j].y * v[j].y) + (v[j].z * v[j].z + v[j].w * v[j].w);
        const float rstd = rsqrtf(wave_sum(s) * (1.f / DM) + 1e-6f);
        u4* o16 = (u4*)(H + (size_t)row * DM) + lane;
#pragma unroll
        for (int jj = 0; jj < 2; ++jj) { const f4 y0 = v[2 * jj] * rstd * (sc[2 * jj] + 1.f) + sh[2 * jj], y1 = v[2 * jj + 1] * rstd * (sc[2 * jj + 1] + 1.f) + sh[2 * jj + 1];
            u4 o; o.x = pkbf(y0.x, y0.y); o.y = pkbf(y0.z, y0.w); o.z = pkbf(y1.x, y1.y); o.w = pkbf(y1.z, y1.w); o16[64 * jj] = o; }
#pragma unroll
        for (int j = 0; j < 4; ++j) { v[j] = vn[j]; sh[j] = shn[j]; sc[j] = scn[j]; }
    }
}
#undef FI
__device__ __forceinline__ void mgnorm_phase(const bfu* MG, bfu* OUT, const float* betaA, const float* betaL) {
    int tid_ = threadIdx.x; asm volatile("" : "+v"(tid_));
    const int lane = tid_ & 63, gw = blockIdx.x * 8 + (tid_ >> 6), NGW = gridDim.x * 8;
    const float* bp = lane < 32 ? betaA + lane * 16 : betaL + (lane - 32) * 16;
    float be[16];
#pragma unroll
    for (int e = 0; e < 4; ++e) { const f4 b = ((const f4*)bp)[e]; be[4 * e] = b.x; be[4 * e + 1] = b.y; be[4 * e + 2] = b.z; be[4 * e + 3] = b.w; }
    for (int row0 = gw; row0 < MT; row0 += 4 * NGW) {
        u4 ra[4], rb[4];
#pragma unroll
        for (int i = 0; i < 4; ++i) { const int row = row0 + i * NGW; if (row < MT) { const u4* rp = (const u4*)(MG + (size_t)row * DM + lane * 16); ra[i] = rp[0]; rb[i] = rp[1]; } }
#pragma unroll
        for (int i = 0; i < 4; ++i) { const int row = row0 + i * NGW; if (row < MT) {
            const unsigned wv[8] = {ra[i].x, ra[i].y, ra[i].z, ra[i].w, rb[i].x, rb[i].y, rb[i].z, rb[i].w};
            float f[16]; float s = 0.f;
#pragma unroll
            for (int e = 0; e < 8; ++e) { f[2 * e] = bflo(wv[e]); f[2 * e + 1] = bfhi(wv[e]); s += f[2 * e] * f[2 * e] + f[2 * e + 1] * f[2 * e + 1]; }
#pragma unroll
            for (int o = 1; o < 32; o <<= 1) s += __shfl_xor(s, o);
            const float rstd = rsqrtf(s * (1.f / 512.f) + 1e-6f);
            u4 oa, ob;
            oa.x = pkbf(f[0] * rstd * be[0], f[1] * rstd * be[1]); oa.y = pkbf(f[2] * rstd * be[2], f[3] * rstd * be[3]);
            oa.z = pkbf(f[4] * rstd * be[4], f[5] * rstd * be[5]); oa.w = pkbf(f[6] * rstd * be[6], f[7] * rstd * be[7]);
            ob.x = pkbf(f[8] * rstd * be[8], f[9] * rstd * be[9]); ob.y = pkbf(f[10] * rstd * be[10], f[11] * rstd * be[11]);
            ob.z = pkbf(f[12] * rstd * be[12], f[13] * rstd * be[13]); ob.w = pkbf(f[14] * rstd * be[14], f[15] * rstd * be[15]);
            u4* wp = (u4*)(OUT + (size_t)row * DM + lane * 16); wp[0] = oa; wp[1] = ob; } }
    }
}
__device__ __forceinline__ void fix_phase(float* XS, const float* part, int nch) {
    int tid_ = threadIdx.x; asm volatile("" : "+v"(tid_));
    const int lane = tid_ & 63, gw = blockIdx.x * 8 + (tid_ >> 6), NGW = gridDim.x * 8;
    for (int row = gw; row < MS; row += NGW) {
        f4* xr = (f4*)(XS + (size_t)row * DM) + lane; const f4* pp = (const f4*)(part + (size_t)row * DM) + lane;
        f4 v[4];
#pragma unroll
        for (int j = 0; j < 4; ++j) v[j] = xr[64 * j];
        for (int ch = 0; ch < nch; ch += 4) {
            f4 t[4][4];
#pragma unroll
            for (int c2 = 0; c2 < 4; ++c2)
#pragma unroll
                for (int j = 0; j < 4; ++j) t[c2][j] = (ch + c2 < nch) ? pp[(size_t)(ch + c2) * (1024 * 1024 / 4) + 64 * j] : (f4){0.f, 0.f, 0.f, 0.f};
#pragma unroll
            for (int c2 = 0; c2 < 4; ++c2)
#pragma unroll
                for (int j = 0; j < 4; ++j) v[j] += t[c2][j];
        }
#pragma unroll
        for (int j = 0; j < 4; ++j) xr[64 * j] = v[j];
    }
}
__device__ __forceinline__ void attn_item(int idx, const bfu* Z, const float* qg, const float* kg, const float* sinks, bfu* MG, float* outk, float* outv, unsigned char* lds) {
    int tid_ = threadIdx.x; asm volatile("" : "+v"(tid_));
    const int tid = tid_, lane = tid & 63, wave = __builtin_amdgcn_readfirstlane(tid >> 6);
    const int b = idx >> 5, nb = (idx >> 1) & 15, kvh = idx & 1, R0 = b * 2048 + nb * 128;
    bfu* Ks = (bfu*)lds;
    bfu* Vt = (bfu*)(lds + 36864);
#ifdef DBG_ZERO_LDS
    for (int i = tid; i < 70656 / 16; i += 512) ((u4*)lds)[i] = (u4){0u, 0u, 0u, 0u};
    __syncthreads();
#endif
    {
        const int kr = tid >> 1, half = tid & 1;
        const bool ok = (nb > 0) || (kr >= 128);
        u4 kw[4], vw[4];
        if (ok) { const u4* kp = (const u4*)(Z + (size_t)(R0 - 128 + kr) * INC + 512 + kvh * 64 + half * 32); const u4* vp = (const u4*)(Z + (size_t)(R0 - 128 + kr) * INC + 640 + kvh * 64 + half * 32);
#pragma unroll
            for (int e = 0; e < 4; ++e) { kw[e] = kp[e]; vw[e] = vp[e]; } }
        else {
#pragma unroll
            for (int e = 0; e < 4; ++e) { kw[e] = (u4){0u, 0u, 0u, 0u}; vw[e] = (u4){0u, 0u, 0u, 0u}; } }
        float kf[32]; float ss = 0.f;
#pragma unroll
        for (int e = 0; e < 4; ++e) { const unsigned ww[4] = {kw[e].x, kw[e].y, kw[e].z, kw[e].w};
#pragma unroll
            for (int t = 0; t < 4; ++t) { kf[8 * e + 2 * t] = bflo(ww[t]); kf[8 * e + 2 * t + 1] = bfhi(ww[t]); } }
#pragma unroll
        for (int e = 0; e < 32; ++e) ss += kf[e] * kf[e];
        ss += __shfl_xor(ss, 1);
        const float rs = rsqrtf(ss * (1.f / 64.f) + 1e-6f);
#pragma unroll
        for (int e = 0; e < 32; ++e) kf[e] = kf[e] * rs * kg[half * 32 + e];
        u4* kd = (u4*)(Ks + kr * 72 + half * 32);
#pragma unroll
        for (int e = 0; e < 4; ++e) { u4 o; o.x = pkbf(kf[8 * e], kf[8 * e + 1]); o.y = pkbf(kf[8 * e + 2], kf[8 * e + 3]); o.z = pkbf(kf[8 * e + 4], kf[8 * e + 5]); o.w = pkbf(kf[8 * e + 6], kf[8 * e + 7]); kd[e] = o; }
#pragma unroll
        for (int e = 0; e < 4; ++e) { const unsigned ww[4] = {vw[e].x, vw[e].y, vw[e].z, vw[e].w};
#pragma unroll
            for (int t = 0; t < 4; ++t) { Vt[(half * 32 + 8 * e + 2 * t) * 264 + kr] = (bfu)(ww[t] & 0xffffu); Vt[(half * 32 + 8 * e + 2 * t + 1) * 264 + kr] = (bfu)(ww[t] >> 16); } }
        if (nb == 15 && kr >= 128) {
            float* ko = outk + ((size_t)(b * 128 + kr - 128) * 2 + kvh) * 64 + half * 32; float* vo = outv + ((size_t)(b * 128 + kr - 128) * 2 + kvh) * 64 + half * 32;
#pragma unroll
            for (int e = 0; e < 8; ++e) ((f4*)ko)[e] = (f4){kf[4 * e], kf[4 * e + 1], kf[4 * e + 2], kf[4 * e + 3]};
#pragma unroll
            for (int e = 0; e < 4; ++e) { const unsigned ww[4] = {vw[e].x, vw[e].y, vw[e].z, vw[e].w};
                ((f4*)vo)[2 * e] = (f4){bflo(ww[0]), bfhi(ww[0]), bflo(ww[1]), bfhi(ww[1])}; ((f4*)vo)[2 * e + 1] = (f4){bflo(ww[2]), bfhi(ww[2]), bflo(ww[3]), bfhi(ww[3])}; }
        }
    }
    __syncthreads();
    const int q = lane & 31, hi = lane >> 5;
#pragma unroll 1
    for (int itk = 0; itk < 2; ++itk) {
        const int task = wave + 8 * itk, g = task & 3, qs = task >> 2, h = kvh * 4 + g;
        int qq = q; asm volatile("" : "+v"(qq));
        const bfu* qp = Z + (size_t)(R0 + 32 * qs + q) * INC + h * 64 + hi * 8;
        float qv[32]; float ss = 0.f;
#pragma unroll
        for (int ds = 0; ds < 4; ++ds) { const u4 raw = *(const u4*)(qp + 16 * ds); const unsigned ww[4] = {raw.x, raw.y, raw.z, raw.w};
#pragma unroll
            for (int t = 0; t < 4; ++t) { qv[8 * ds + 2 * t] = bflo(ww[t]); qv[8 * ds + 2 * t + 1] = bfhi(ww[t]); } }
#pragma unroll
        for (int e = 0; e < 32; ++e) ss += qv[e] * qv[e];
        ss += __shfl_xor(ss, 32);
        const float qsc = rsqrtf(ss * (1.f / 64.f) + 1e-6f) * 0.125f;
        s16x8 qf[4];
#pragma unroll
        for (int ds = 0; ds < 4; ++ds) { const float* gp = qg + 16 * ds + 8 * hi; u4 o;
            o.x = pkbf(qv[8 * ds] * qsc * gp[0], qv[8 * ds + 1] * qsc * gp[1]); o.y = pkbf(qv[8 * ds + 2] * qsc * gp[2], qv[8 * ds + 3] * qsc * gp[3]);
            o.z = pkbf(qv[8 * ds + 4] * qsc * gp[4], qv[8 * ds + 5] * qsc * gp[5]); o.w = pkbf(qv[8 * ds + 6] * qsc * gp[6], qv[8 * ds + 7] * qsc * gp[7]);
            qf[ds] = __builtin_bit_cast(s16x8, o); }
        const float slope = exp2f(-(float)(h + 1)), sink = sinks[h];
        const int jt0 = (nb == 0) ? 4 : qs;
        f16v S[5];
        float m = sink;
#pragma unroll
        for (int x = 0; x < 5; ++x) {
            const int jt = qs + x;
            if (jt >= jt0) {
                f16v acc;
#pragma unroll
                for (int r = 0; r < 16; ++r) acc[r] = 0.f;
#pragma unroll
                for (int ds = 0; ds < 4; ++ds) { const s16x8 a = *(const s16x8*)(Ks + (32 * jt + q) * 72 + 16 * ds + 8 * hi); acc = __builtin_amdgcn_mfma_f32_32x32x16_bf16(a, qf[ds], acc, 0, 0, 0); }
#pragma unroll
                for (int r = 0; r < 16; ++r) { const int dist = 128 + 32 * qs + qq - (32 * jt + crow(r, hi)); const bool valid = dist >= 0 && dist <= 128;
                    const float sv = valid ? acc[r] - slope * (float)dist : -1e30f; S[x][r] = sv; m = fmaxf(m, sv); }
            } else {
#pragma unroll
                for (int r = 0; r < 16; ++r) S[x][r] = -1e30f;
            }
        }
        m = fmaxf(m, __shfl_xor(m, 32));
        float l = 0.f;
#pragma unroll
        for (int x = 0; x < 5; ++x)
#pragma unroll
            for (int r = 0; r < 16; ++r) { const float pe = __expf(S[x][r] - m); S[x][r] = pe; l += pe; }
        l += __shfl_xor(l, 32);
        l += __expf(sink - m);
        const float rinv = 1.f / l;
        f16v o0, o1;
#pragma unroll
        for (int r = 0; r < 16; ++r) { o0[r] = 0.f; o1[r] = 0.f; }
#pragma unroll
        for (int x = 0; x < 5; ++x) {
            const int jt = qs + x;
            if (jt >= jt0) {
#pragma unroll
                for (int s2 = 0; s2 < 2; ++s2) {
                    u4 pa; pa.x = pkbf(S[x][8 * s2], S[x][8 * s2 + 1]); pa.y = pkbf(S[x][8 * s2 + 2], S[x][8 * s2 + 3]); pa.z = pkbf(S[x][8 * s2 + 4], S[x][8 * s2 + 5]); pa.w = pkbf(S[x][8 * s2 + 6], S[x][8 * s2 + 7]);
                    const s16x8 A = __builtin_bit_cast(s16x8, pa);
                    const bfu* vp0 = Vt + q * 264 + 32 * jt + 16 * s2 + 4 * hi; const bfu* vp1 = vp0 + 32 * 264;
                    const u2 a0 = *(const u2*)vp0, a1 = *(const u2*)(vp0 + 8), b0 = *(const u2*)vp1, b1 = *(const u2*)(vp1 + 8);
                    const u4 B0 = {a0.x, a0.y, a1.x, a1.y}, B1 = {b0.x, b0.y, b1.x, b1.y};
                    o0 = __builtin_amdgcn_mfma_f32_32x32x16_bf16(A, __builtin_bit_cast(s16x8, B0), o0, 0, 0, 0);
                    o1 = __builtin_amdgcn_mfma_f32_32x32x16_bf16(A, __builtin_bit_cast(s16x8, B1), o1, 0, 0, 0);
                }
            }
        }
        bfu* op = MG + (size_t)(R0 + 32 * qs) * DM + h * 64 + q;
#pragma unroll
        for (int r = 0; r < 16; ++r) { const int qr = crow(r, hi); const float rl = __shfl(rinv, qr);
            op[(size_t)qr * DM] = tobf(o0[r] * rl); op[(size_t)qr * DM + 32] = tobf(o1[r] * rl); }
    }
}

__device__ __forceinline__ void sattn_item(int b, const bfu* Z, const float* ck, const float* cv, const float* qg, const float* kg, const float* sinks, bfu* MG, float* outk, float* outv, unsigned char* lds) {
    int tid_ = threadIdx.x; asm volatile("" : "+v"(tid_));
    const int tid = tid_, lane = tid & 63, wave = __builtin_amdgcn_readfirstlane(tid >> 6);
    bfu* KK = (bfu*)lds;
    bfu* VV = (bfu*)(lds + 34816);
    float* QS = (float*)(lds + 69632);
    float* SC = (float*)(lds + 86016);
    const float* ckb = ck + (size_t)b * 16384; const float* cvb = cv + (size_t)b * 16384;
    float* okb = outk + (size_t)b * 16384; float* ovb = outv + (size_t)b * 16384;
#pragma unroll
    for (int it = 0; it < 8; ++it) { const int i = tid + 512 * it, row = i >> 5, c4 = (i & 31) * 4;
        const f4 k4 = ((const f4*)ckb)[i], v4 = ((const f4*)cvb)[i];
        u2 o; o.x = pkbf(k4.x, k4.y); o.y = pkbf(k4.z, k4.w); *(u2*)(KK + row * 128 + c4) = o;
        o.x = pkbf(v4.x, v4.y); o.y = pkbf(v4.z, v4.w); *(u2*)(VV + row * 128 + c4) = o;
        if (row >= 8) { ((f4*)okb)[i - 256] = k4; ((f4*)ovb)[i - 256] = v4; } }
    {
        const int pair = tid >> 5, i = pair >> 1, kvh = pair & 1, dd = (tid & 31) * 2;
        const bfu* zr = Z + (size_t)(MP + 8 * b + i) * INC;
        const unsigned kwd = *(const unsigned*)(zr + 512 + kvh * 64 + dd), vwd = *(const unsigned*)(zr + 640 + kvh * 64 + dd);
        float k0 = bflo(kwd), k1 = bfhi(kwd); float ss = k0 * k0 + k1 * k1;
#pragma unroll
        for (int o = 1; o < 32; o <<= 1) ss += __shfl_xor(ss, o);
        const float rs = rsqrtf(ss * (1.f / 64.f) + 1e-6f);
        k0 = k0 * rs * kg[dd]; k1 = k1 * rs * kg[dd + 1];
        *(unsigned*)(KK + (128 + i) * 128 + kvh * 64 + dd) = pkbf(k0, k1); *(unsigned*)(VV + (128 + i) * 128 + kvh * 64 + dd) = vwd;
        float* ko = okb + (size_t)(120 + i) * 128 + kvh * 64 + dd; ko[0] = k0; ko[1] = k1;
        float* vo = ovb + (size_t)(120 + i) * 128 + kvh * 64 + dd; vo[0] = bflo(vwd); vo[1] = bfhi(vwd);
    }
    {
        const int pair = tid >> 3, i = pair >> 3, h = pair & 7, d0 = (tid & 7) * 8;
        const u4 raw = *(const u4*)(Z + (size_t)(MP + 8 * b + i) * INC + h * 64 + d0); const unsigned ww[4] = {raw.x, raw.y, raw.z, raw.w};
        float qv[8]; float ss = 0.f;
#pragma unroll
        for (int t = 0; t < 4; ++t) { qv[2 * t] = bflo(ww[t]); qv[2 * t + 1] = bfhi(ww[t]); ss += qv[2 * t] * qv[2 * t] + qv[2 * t + 1] * qv[2 * t + 1]; }
        ss += __shfl_xor(ss, 1); ss += __shfl_xor(ss, 2); ss += __shfl_xor(ss, 4);
        const float rs = rsqrtf(ss * (1.f / 64.f) + 1e-6f) * 0.125f;
#pragma unroll
        for (int e = 0; e < 8; ++e) QS[i * 512 + h * 64 + d0 + e] = qv[e] * rs * qg[d0 + e];
    }
    __syncthreads();
    {
        const int i = lane >> 3, h = lane & 7, kvh = h >> 2;
        float qr[64];
#pragma unroll
        for (int e = 0; e < 16; ++e) { const f4 t = *(const f4*)&QS[i * 512 + h * 64 + 4 * e]; qr[4 * e] = t.x; qr[4 * e + 1] = t.y; qr[4 * e + 2] = t.z; qr[4 * e + 3] = t.w; }
        const float slope = exp2f(-(float)(h + 1));
        for (int j = wave; j < 136; j += 8) {
            const u4* kp = (const u4*)(KK + j * 128 + kvh * 64); float d = 0.f;
#pragma unroll
            for (int c = 0; c < 8; ++c) { const u4 kw = kp[c]; const unsigned ww[4] = {kw.x, kw.y, kw.z, kw.w};
#pragma unroll
                for (int t = 0; t < 4; ++t) d += qr[8 * c + 2 * t] * bflo(ww[t]) + qr[8 * c + 2 * t + 1] * bfhi(ww[t]); }
            const int dist = 128 + i - j; const bool valid = dist >= 0 && dist <= 128;
            SC[lane * 137 + j] = valid ? d - slope * (float)dist : -1e30f;
        }
    }
    __syncthreads();
    {
        const int pair = tid >> 3, sub = tid & 7, h = pair & 7; const float sink = sinks[h];
        float m = sink;
        for (int j = sub; j < 136; j += 8) m = fmaxf(m, SC[pair * 137 + j]);
        m = fmaxf(m, __shfl_xor(m, 1)); m = fmaxf(m, __shfl_xor(m, 2)); m = fmaxf(m, __shfl_xor(m, 4));
        float l = 0.f;
        for (int j = sub; j < 136; j += 8) { const float pe = __expf(SC[pair * 137 + j] - m); SC[pair * 137 + j] = pe; l += pe; }
        l += __shfl_xor(l, 1); l += __shfl_xor(l, 2); l += __shfl_xor(l, 4);
        l += __expf(sink - m);
        const float rl = 1.f / l;
        for (int j = sub; j < 136; j += 8) SC[pair * 137 + j] *= rl;
    }
    __syncthreads();
    {
        const int pair = tid >> 3, dc = tid & 7, i = pair >> 3, h = pair & 7, kvh = h >> 2;
        float acc[8];
#pragma unroll
        for (int e = 0; e < 8; ++e) acc[e] = 0.f;
        for (int j = 0; j < 136; ++j) { const float pj = SC[pair * 137 + j]; const u4 vw = *(const u4*)(VV + j * 128 + kvh * 64 + dc * 8); const unsigned ww[4] = {vw.x, vw.y, vw.z, vw.w};
#pragma unroll
            for (int t = 0; t < 4; ++t) { acc[2 * t] += pj * bflo(ww[t]); acc[2 * t + 1] += pj * bfhi(ww[t]); } }
        u4 o; o.x = pkbf(acc[0], acc[1]); o.y = pkbf(acc[2], acc[3]); o.z = pkbf(acc[4], acc[5]); o.w = pkbf(acc[6], acc[7]);
        *(u4*)(MG + (size_t)(MP + 8 * b + i) * DM + h * 64 + dc * 8) = o;
    }
}
template <bool SAMPLE>
__device__ __forceinline__ void lru_item(int idx, const bfu* Z, const float* st_conv, const float* st_lru, const float* convw, const float* convb, const float* wrg, const float* brg,
                                         const float* wig, const float* big, const float* lam, bfu* MG, float* out_conv, float* out_lru, unsigned char* lds) {
    constexpr int L = SAMPLE ? 8 : 64, NT = SAMPLE ? 1 : 32, XROWS = SAMPLE ? 88 : 67;
    int tid_ = threadIdx.x; asm volatile("" : "+v"(tid_));
    const int tid = tid_, lane = tid & 63, wave = __builtin_amdgcn_readfirstlane(tid >> 6);
    const int n = idx & 7, bb = idx >> 3;
    const int rowbase = SAMPLE ? MP + bb * 64 : bb * 2048, ch0 = n * 64;
    float* XRS = (float*)lds;
    bfu* XCB = (bfu*)(lds + 22528);
    float* XCF = (float*)(lds + 31744);
    bfu* WRT = (bfu*)(lds + 48128);
    bfu* WIT = (bfu*)(lds + 57344);
    float* AA = (float*)(lds + 66560);
    float* UU = (float*)(lds + 82944);
    bfu* GR = (bfu*)(lds + 99328);
    float* COMB = (float*)(lds + 107520);
    float* HCAR = (float*)(lds + 111616);
    {
        const int c = tid >> 3, d0 = (tid & 7) * 8;
        const f4* rp = (const f4*)(wrg + (size_t)n * 4096 + c * 64 + d0); const f4* ip = (const f4*)(wig + (size_t)n * 4096 + c * 64 + d0);
        const f4 r0 = rp[0], r1 = rp[1], i0 = ip[0], i1 = ip[1];
        const float rv[8] = {r0.x, r0.y, r0.z, r0.w, r1.x, r1.y, r1.z, r1.w}, iv[8] = {i0.x, i0.y, i0.z, i0.w, i1.x, i1.y, i1.z, i1.w};
#pragma unroll
        for (int e = 0; e < 8; ++e) { WRT[(d0 + e) * 72 + c] = tobf(rv[e]); WIT[(d0 + e) * 72 + c] = tobf(iv[e]); }
        if (tid < 64) HCAR[tid] = 0.f;
    }
    const int ct_t = tid >> 3, ct_c = (tid & 7) * 8;
    float cw[4][8], cbv[8];
#pragma unroll
    for (int e = 0; e < 8; ++e) { cbv[e] = convb[ch0 + ct_c + e];
#pragma unroll
        for (int tap = 0; tap < 4; ++tap) cw[tap][e] = convw[tap * 512 + ch0 + ct_c + e]; }
    const int fr = lane & 15, fq = lane >> 4, rt = wave >> 1;
    float g_br[2], g_bi[2], g_sp[2];
#pragma unroll
    for (int cc = 0; cc < 2; ++cc) { const int d = 16 * (2 * (wave & 1) + cc) + fr; g_br[cc] = brg[ch0 + d]; g_bi[cc] = big[ch0 + d];
        const float x = -lam[ch0 + d]; g_sp[cc] = fmaxf(x, 0.f) + log1pf(__expf(-fabsf(x))); }
    u4 pxr[2], pgr; f4 pst[2][2];
    auto prefetch = [&](int tt) {
        const int t0 = tt * 64;
#pragma unroll
        for (int k = 0; k < 2; ++k) { const int i = tid + 512 * k; pxr[k] = (u4){0u, 0u, 0u, 0u};
            if (i < XROWS * 8) { const int xrow = i >> 3, cc = (i & 7) * 8;
                if (SAMPLE) { const int seg = xrow / 11, rr = xrow % 11;
                    if (rr < 3) { const f4* sp = (const f4*)(st_conv + ((size_t)(bb * 8 + seg) * 3 + rr) * 512 + ch0 + cc); pst[k][0] = sp[0]; pst[k][1] = sp[1]; }
                    else pxr[k] = *(const u4*)(Z + (size_t)(rowbase + seg * 8 + rr - 3) * INC + 768 + ch0 + cc); }
                else { const int trel = t0 - 3 + xrow; if (trel >= 0) pxr[k] = *(const u4*)(Z + (size_t)(rowbase + trel) * INC + 768 + ch0 + cc); } } }
        pgr = *(const u4*)(Z + (size_t)(rowbase + t0 + (tid >> 3)) * INC + 1280 + ch0 + (tid & 7) * 8);
    };
    prefetch(0);
    for (int tt = 0; tt < NT; ++tt) {
        const int t0 = tt * 64;
#pragma unroll
        for (int k = 0; k < 2; ++k) { const int i = tid + 512 * k;
            if (i < XROWS * 8) { const int xrow = i >> 3, cc = (i & 7) * 8; f4 lo, hi4;
                if (SAMPLE && (xrow % 11) < 3) { lo = pst[k][0]; hi4 = pst[k][1]; }
                else { lo = (f4){bflo(pxr[k].x), bfhi(pxr[k].x), bflo(pxr[k].y), bfhi(pxr[k].y)}; hi4 = (f4){bflo(pxr[k].z), bfhi(pxr[k].z), bflo(pxr[k].w), bfhi(pxr[k].w)}; }
                *(f4*)&XRS[xrow * 64 + cc] = lo; *(f4*)&XRS[xrow * 64 + cc + 4] = hi4; } }
        *(u4*)(GR + (tid >> 3) * 64 + (tid & 7) * 8) = pgr;
        __syncthreads();
        if (tt + 1 < NT) prefetch(tt + 1);
        if (SAMPLE) {
#pragma unroll
            for (int k = 0; k < 3; ++k) { const int i = tid + 512 * k, seg = i / 192, rr = (i % 192) >> 6, c = i & 63;
                out_conv[((size_t)(bb * 8 + seg) * 3 + rr) * 512 + ch0 + c] = XRS[(seg * 11 + 8 + rr) * 64 + c]; }
        } else if (tt == NT - 1) {
            if (tid < 192) { const int rr = tid >> 6, c = tid & 63; out_conv[((size_t)bb * 3 + rr) * 512 + ch0 + c] = XRS[(64 + rr) * 64 + c]; }
        }
        {
            const int seg = ct_t / L, tl = ct_t % L, xr0 = seg * (L + 3) + tl;
            float v[8];
#pragma unroll
            for (int e = 0; e < 8; ++e) v[e] = cbv[e];
#pragma unroll
            for (int tap = 0; tap < 4; ++tap) { const f4 a = *(const f4*)&XRS[(xr0 + tap) * 64 + ct_c], b4 = *(const f4*)&XRS[(xr0 + tap) * 64 + ct_c + 4];
                v[0] += cw[tap][0] * a.x; v[1] += cw[tap][1] * a.y; v[2] += cw[tap][2] * a.z; v[3] += cw[tap][3] * a.w;
                v[4] += cw[tap][4] * b4.x; v[5] += cw[tap][5] * b4.y; v[6] += cw[tap][6] * b4.z; v[7] += cw[tap][7] * b4.w; }
            *(f4*)&XCF[ct_t * 64 + ct_c] = (f4){v[0], v[1], v[2], v[3]}; *(f4*)&XCF[ct_t * 64 + ct_c + 4] = (f4){v[4], v[5], v[6], v[7]};
            u4 o; o.x = pkbf(v[0], v[1]); o.y = pkbf(v[2], v[3]); o.z = pkbf(v[4], v[5]); o.w = pkbf(v[6], v[7]);
            *(u4*)(XCB + ct_t * 72 + ct_c) = o;
        }
        __syncthreads();
        {
            const s16x8 a0 = *(const s16x8*)(XCB + (16 * rt + fr) * 72 + 8 * fq), a1 = *(const s16x8*)(XCB + (16 * rt + fr) * 72 + 32 + 8 * fq);
#pragma unroll
            for (int cc = 0; cc < 2; ++cc) { const int ct = 2 * (wave & 1) + cc;
                const bfu* wr_ = WRT + (16 * ct + fr) * 72 + 8 * fq; const bfu* wi_ = WIT + (16 * ct + fr) * 72 + 8 * fq;
                f4 ar = {0.f, 0.f, 0.f, 0.f}, ai = {0.f, 0.f, 0.f, 0.f};
                ar = __builtin_amdgcn_mfma_f32_16x16x32_bf16(a0, *(const s16x8*)wr_, ar, 0, 0, 0); ar = __builtin_amdgcn_mfma_f32_16x16x32_bf16(a1, *(const s16x8*)(wr_ + 32), ar, 0, 0, 0);
                ai = __builtin_amdgcn_mfma_f32_16x16x32_bf16(a0, *(const s16x8*)wi_, ai, 0, 0, 0); ai = __builtin_amdgcn_mfma_f32_16x16x32_bf16(a1, *(const s16x8*)(wi_ + 32), ai, 0, 0, 0);
                const int d = 16 * ct + fr;
#pragma unroll
                for (int e = 0; e < 4; ++e) { const int t = 16 * rt + 4 * fq + e; const float xc = XCF[t * 64 + d];
                    const float r = sigm(ar[e] + g_br[cc]), gi = sigm(ai[e] + g_bi[cc]);
                    const float la = -8.f * r * g_sp[cc]; const float a = __expf(la); const float u = __builtin_amdgcn_sqrtf(fmaxf(1.f - a * a, 0.f)) * gi * xc;
                    AA[t * 64 + d] = a; UU[t * 64 + d] = u; }
            }
        }
        __syncthreads();
        float hl[8], pl[8];
        {
            float h = 0.f, P = 1.f;
#pragma unroll
            for (int i = 0; i < 8; ++i) { const float a = AA[(8 * wave + i) * 64 + lane], u = UU[(8 * wave + i) * 64 + lane]; h = a * h + u; P *= a; hl[i] = h; pl[i] = P; }
            if (!SAMPLE) { COMB[(wave * 64 + lane) * 2] = P; COMB[(wave * 64 + lane) * 2 + 1] = h; }
        }
        if (!SAMPLE) __syncthreads();
        float carry;
        if (SAMPLE) carry = st_lru[(size_t)(bb * 8 + wave) * 512 + ch0 + lane];
        else { carry = HCAR[lane];
            float cp[7], chh[7];
#pragma unroll
            for (int s = 0; s < 7; ++s) { cp[s] = COMB[(s * 64 + lane) * 2]; chh[s] = COMB[(s * 64 + lane) * 2 + 1]; }
#pragma unroll
            for (int s = 0; s < 7; ++s) carry = (s < wave) ? cp[s] * carry + chh[s] : carry; }
        float hfin = 0.f;
#pragma unroll
        for (int i = 0; i < 8; ++i) { const int t = 8 * wave + i; const float h = hl[i] + pl[i] * carry; hfin = h;
            const float gr = bf1(GR[t * 64 + lane]);
            MG[(size_t)(rowbase + t0 + t) * DM + 512 + ch0 + lane] = tobf(h * gelu_tanh(gr)); }
        if (SAMPLE) out_lru[(size_t)(bb * 8 + wave) * 512 + ch0 + lane] = hfin;
        else if (tt == NT - 1 && wave == 7) out_lru[(size_t)bb * 512 + ch0 + lane] = hfin;
        __syncthreads();
        if (!SAMPLE && wave == 7) HCAR[lane] = hfin;
    }
}
#define LAS __attribute__((address_space(3)))
#define XB_TMO      128
#define XB_XCNT(j)  (256  + 64 * (j))
#define XB_XSUB(j)  (1280 + 64 * (j))
#define XB_XGEN(j)  (2304 + 64 * (j))
#define XB_TOP      3328
#define XB_TOPGEN   3392
#define XCD_BAR_WORDS 3456
#define XB_SPIN_CAP (1u << 18)

__device__ __forceinline__ unsigned xb_ld(unsigned* p)              { return __hip_atomic_load(p, __ATOMIC_RELAXED, __HIP_MEMORY_SCOPE_AGENT); }
__device__ __forceinline__ unsigned xb_add(unsigned* p, unsigned v) { return __hip_atomic_fetch_add(p, v, __ATOMIC_RELAXED, __HIP_MEMORY_SCOPE_AGENT); }
__device__ __forceinline__ unsigned xb_xcc_id() { return (unsigned)__builtin_amdgcn_s_getreg((3 << 11) | 20) & 0xFu; }
#define XB_SPIN(cond, bar) do { unsigned _sp = 0; while (cond) { __builtin_amdgcn_s_sleep(1); \
    if ((++_sp & 255u) == 0u) { if (xb_ld(&(bar)[XB_TMO])) break; if (_sp > XB_SPIN_CAP) { atomicAdd(&(bar)[XB_TMO], 1u); break; } } } } while (0)

struct XcdBarrier {
    unsigned* bar; unsigned x;
    volatile LAS unsigned* st;
};

__device__ __forceinline__ XcdBarrier xcd_barrier_post(unsigned* bar, volatile LAS unsigned* st) {
    XcdBarrier b; b.bar = bar; b.x = xb_xcc_id(); b.st = st;
    if (threadIdx.x == 0) (void)xb_add(&bar[XB_XCNT(b.x)], 1u);
    return b;
}
__device__ __forceinline__ void xcd_barrier_complete(unsigned* bar, unsigned x, unsigned& nloc, unsigned& nx) {
    const unsigned G = gridDim.x * gridDim.y * gridDim.z;
    unsigned sum, cnt, mine, sp = 0u;
    for (;;) {
        sum = 0u; cnt = 0u; mine = 0u;
#pragma unroll
        for (unsigned j = 0; j < 16; ++j) { const unsigned c = xb_ld(&bar[XB_XCNT(j)]); sum += c; cnt += (c > 0u) ? 1u : 0u; mine = (j == x) ? c : mine; }
        if (sum == G) break;
        __builtin_amdgcn_s_sleep(1);
        if ((++sp & 255u) == 0u) { if (xb_ld(&bar[XB_TMO])) break; if (sp > XB_SPIN_CAP) { atomicAdd(&bar[XB_TMO], 1u); break; } }
    }
    nloc = mine > 0u ? mine : 1u; nx = cnt > 0u ? cnt : 1u;
}

__device__ __forceinline__ void xcd_barrier(const XcdBarrier& b) {
    asm volatile("s_waitcnt vmcnt(0)" ::: "memory");
    __syncthreads();
    if (threadIdx.x == 0) {
        unsigned* bar = b.bar;
        __builtin_amdgcn_s_waitcnt(0);
        unsigned nloc = b.st[0], nx = b.st[1];
        if (nloc == 0u) { xcd_barrier_complete(bar, b.x, nloc, nx); b.st[0] = nloc; b.st[1] = nx; }
        const unsigned old = xb_add(&bar[XB_XSUB(b.x)], 1u);
        const unsigned gen = old / nloc;
        if (old + 1u == (gen + 1u) * nloc) {
            __builtin_amdgcn_fence(__ATOMIC_RELEASE, "agent");
            asm volatile("s_waitcnt vmcnt(0)" ::: "memory");
            const unsigned og = xb_add(&bar[XB_TOP], 1u);
            const unsigned tg = og / nx;
            if (og + 1u == (tg + 1u) * nx) xb_add(&bar[XB_TOPGEN], 1u);
            else XB_SPIN(xb_ld(&bar[XB_TOPGEN]) == tg, bar);
            __builtin_amdgcn_fence(__ATOMIC_ACQUIRE, "agent");
            xb_add(&bar[XB_XGEN(b.x)], 1u);
            asm volatile("s_waitcnt vmcnt(0)" ::: "memory");
        } else {
            XB_SPIN(xb_ld(&bar[XB_XGEN(b.x)]) == gen, bar);
            __builtin_amdgcn_fence(__ATOMIC_ACQUIRE, "agent");
            asm volatile("s_waitcnt vmcnt(0)" ::: "memory");
        }
    }
    __syncthreads();
}
#ifndef MXMASK
#define MXMASK 15
#endif
constexpr int MX_C = 128, MX_A = 512, MX_B = 128, MX_D = 128, MX_ALL = MX_C + MX_A + MX_B + MX_D;
__device__ __forceinline__ void mixer_phase(const Params& p, int l, unsigned char* lds, unsigned* ctr, volatile int* slot, int imask = 15) {
    const bfu* Z = (const bfu*)(p.ws + WS_ACT); bfu* MG = (bfu*)(p.ws + WS_MG);
    const float* qg = p.in[14] + l * 64; const float* kg = p.in[15] + l * 64; const float* sinks = p.in[16] + l * 8;
    const float* convw = p.in[17] + l * 2048; const float* convb = p.in[18] + l * 512;
    const float* wrg = p.in[19] + (size_t)l * 32768; const float* brg = p.in[20] + l * 512; const float* wig = p.in[21] + (size_t)l * 32768; const float* big = p.in[22] + l * 512;
    const float* lam = p.in[23] + l * 512;
    float* out = p.out;
    int cur = wq_next(ctr, slot);
    while (cur < MX_ALL) {
        unsigned pre = 0u;
        if (threadIdx.x == 0) pre = atomicAdd(ctr, 1u);
        int it = cur;
        if (it < MX_C) { if (imask & 1) lru_item<false>(it, Z, nullptr, nullptr, convw, convb, wrg, brg, wig, big, lam, MG, out + O_CP + (size_t)l * 16 * 1536, out + O_LP + (size_t)l * 16 * 512, lds); }
        else if ((it -= MX_C) < MX_A) { if (imask & 2) attn_item(it, Z, qg, kg, sinks, MG, out + O_KP + (size_t)l * 262144, out + O_VP + (size_t)l * 262144, lds); }
        else if ((it -= MX_A) < MX_B) { if (imask & 4) sattn_item(it, Z, p.in[2] + (size_t)l * 2097152, p.in[3] + (size_t)l * 2097152, qg, kg, sinks, MG, out + O_KS + (size_t)l * 2097152, out + O_VS + (size_t)l * 2097152, lds); }
        else { it -= MX_B; if (imask & 8) lru_item<true>(it, Z, p.in[4] + (size_t)l * 128 * 1536, p.in[5] + (size_t)l * 128 * 512, convw, convb, wrg, brg, wig, big, lam, MG, out + O_CS + (size_t)l * 128 * 1536, out + O_LS + (size_t)l * 128 * 512, lds); }
        __syncthreads();
        if (threadIdx.x == 0) *slot = (int)pre;
        __syncthreads();
        cur = *slot;
    }
}

__device__ __forceinline__ void grid_barrier(cg::grid_group& grid) {
    asm volatile("s_waitcnt vmcnt(0) lgkmcnt(0)" ::: "memory");
    __syncthreads();
    grid.sync();
    __builtin_amdgcn_fence(__ATOMIC_ACQUIRE, "agent");
    asm volatile("s_waitcnt vmcnt(0)" ::: "memory");
    __syncthreads();
}
#ifndef PH_HI
#define PH_HI 1000
#endif
#ifndef N_PHASES_CUT
#define N_PHASES_CUT 0
#endif
__global__ void __launch_bounds__(512, 2) fwd_kernel(Params p, int ph_lo, int ph_hi) {
    extern __shared__ __attribute__((aligned(16))) unsigned char lds[];
    cg::grid_group grid = cg::this_grid();
    volatile int* slot = (volatile int*)(lds + 131072);
    PG8_LAS unsigned char* lds3 = (PG8_LAS unsigned char*)lds;
    unsigned* ctl = (unsigned*)(p.ws + WS_CTL);
    const bfu* wsW = (const bfu*)(p.ws + WS_W); const float* mod = (const float*)(p.ws + WS_MOD);
    bfu* H = (bfu*)(p.ws + WS_H); bfu* MG = (bfu*)(p.ws + WS_MG); bfu* ACT = (bfu*)(p.ws + WS_ACT);
    float* X = p.out;
    const int G = gridDim.x, bx = blockIdx.x;
    if (threadIdx.x < 2) ((volatile LAS unsigned*)(lds3 + 131072 + 64))[threadIdx.x] = 0u;
    __syncthreads();
    const XcdBarrier xb = xcd_barrier_post(ctl + 4096, (volatile LAS unsigned*)(lds3 + 131072 + 64));
#define SEAM() do { if (ph_hi < 0) grid_barrier(grid); else xcd_barrier(xb); } while (0)
    int ph = 0;
#ifndef PHMASK
#define PHMASK 0xff
#endif
#ifndef DBG_IMASK
#define DBG_IMASK 1
#endif
#ifndef REPMASK
#define REPMASK 0
#endif
#define PHASE(id, ...) do { if (ph >= ph_lo && ph < ph_hi) { if constexpr ((PHMASK >> id) & 1) { const int nrep_ = ((REPMASK >> id) & 1) ? 2 : 1; \
    for (int rep_ = 0; rep_ < nrep_; ++rep_) { __VA_ARGS__; if (rep_ + 1 < nrep_) SEAM(); } } if (ph + 1 < ph_hi) SEAM(); } ++ph; } while (0)
    PHASE(0, prologue_phase(p, lds, ctl + 512 * rep_, slot));
    PHASE(7, { pg8::Gemm g{(const bfu*)(p.ws + WS_SC), (const bfu*)(p.ws + WS_WADA), 256, 2 * NMODC, 1024}; pg8::StaticOrder S; S.init(256, 2 * NMODC, G, bx);
               pg8::EpiMod E{(float*)(p.ws + WS_MOD), p.in[9]}; pg8::gemm_phase<pg8::EpiMod, pg8::StaticOrder, true, true>(lds3, g, S, E); });
    float* XS = X + (size_t)MP * DM; float* PART = (float*)(p.ws + 404 * MiB);
    bfu* XB = (bfu*)(p.ws + 448 * MiB);
    PHASE(1, norm_phase(p.in[0], p.in[1], mod, 0, 1, H, nullptr, 0, nullptr, nullptr));
    for (int l = 0; l < 2; ++l) {
        const bfu* wl = wsW + (size_t)l * W_LAYER; const float* modl = mod + (size_t)l * NCB * NMODC;
        const float* xP = l == 0 ? p.in[0] : X; const float* xS = l == 0 ? p.in[1] : XS;
        PHASE(2, { pg8::Gemm g{H, wl + W_UP1, MT, 5632, 1024}; pg8::StaticOrder S; S.init(MT, 5632, G, bx); pg8::EpiSwiglu E{ACT, DFF};
                pg8::gemm_phase<pg8::EpiSwiglu, pg8::StaticOrder, true, true>(lds3, g, S, E); });
        if (l == 0) PHASE(3, { pg8::Gemm g{ACT, wl + W_DN1, MT, 1024, DFF}; pg8::SplitOrder S; S.init(1024, DFF, G, bx); pg8::EpiResid<0> E{p.in[0], nullptr, nullptr, XB, modl + 2 * DM, 0.5f, PART};
                pg8::gemm_phase<pg8::EpiResid<0>, pg8::SplitOrder, true, true>(lds3, g, S, E); });
        else PHASE(3, { pg8::Gemm g{ACT, wl + W_DN1, MT, 1024, DFF}; pg8::SplitOrder S; S.init(1024, DFF, G, bx); pg8::EpiResid<1> E{nullptr, XB, nullptr, XB, modl + 2 * DM, 0.5f, PART};
                pg8::gemm_phase<pg8::EpiResid<1>, pg8::SplitOrder, true, true>(lds3, g, S, E); });
        PHASE(1, norm_phase(X, xS, modl, 3, 4, H, PART, DFF / 256, XS, XB));
        PHASE(4, { pg8::Gemm g{H, wl + W_IN, MT, INC, 1024}; pg8::StaticOrder S; S.init(MT, INC, G, bx); pg8::EpiPlainBf16 E{ACT, INC};
                pg8::gemm_phase<pg8::EpiPlainBf16, pg8::StaticOrder, true, true>(lds3, g, S, E); });
        PHASE(5, mixer_phase(p, l, lds, ctl + 64 * (1 + l) + 512 * rep_, slot, rep_ ? DBG_IMASK : 15));
        PHASE(6, mgnorm_phase(MG, MG, p.in[24] + l * 512, p.in[25] + l * 512));
        PHASE(3, { pg8::Gemm g{MG, wl + W_OUT, MT, 1024, 1024}; pg8::SplitOrder S; S.init(1024, 1024, G, bx); pg8::EpiResid<1> E{nullptr, XB, nullptr, XB, modl + 5 * DM, 1.0f, PART};
                pg8::gemm_phase<pg8::EpiResid<1>, pg8::SplitOrder, true, true>(lds3, g, S, E); });
        PHASE(1, norm_phase(X, XS, modl, 6, 7, H, PART, 4, XS, XB));
        PHASE(2, { pg8::Gemm g{H, wl + W_UP2, MT, 5632, 1024}; pg8::StaticOrder S; S.init(MT, 5632, G, bx); pg8::EpiSwiglu E{ACT, DFF};
                pg8::gemm_phase<pg8::EpiSwiglu, pg8::StaticOrder, true, true>(lds3, g, S, E); });
        if (l == 0) PHASE(3, { pg8::Gemm g{ACT, wl + W_DN2, MT, 1024, DFF}; pg8::SplitOrder S; S.init(1024, DFF, G, bx); pg8::EpiResid<1> E{nullptr, XB, nullptr, XB, modl + 8 * DM, 0.5f, PART};
                pg8::gemm_phase<pg8::EpiResid<1>, pg8::SplitOrder, true, true>(lds3, g, S, E); });
        else PHASE(3, { pg8::Gemm g{ACT, wl + W_DN2, MT, 1024, DFF}; pg8::SplitOrder S; S.init(1024, DFF, G, bx); pg8::EpiResid<2> E{nullptr, XB, X, nullptr, modl + 8 * DM, 0.5f, PART};
                pg8::gemm_phase<pg8::EpiResid<2>, pg8::SplitOrder, true, true>(lds3, g, S, E); });
        if (l == 0) PHASE(1, norm_phase(X, XS, mod + (size_t)NCB * NMODC, 0, 1, H, PART, DFF / 256, XS, XB));
        else PHASE(1, fix_phase(XS, PART, DFF / 256));
    }
#undef PHASE
}

extern "C" void kernel_launch(void* const* d_in, const int* in_sizes, int n_in, void* d_out, int out_size, void* d_ws, size_t ws_size, hipStream_t stream) {
    static int grid = 0;
    if (grid == 0) {
        if (n_in != 30 || ws_size < 512 * MiB) { fprintf(stderr, "kernel_launch: unexpected n_in %d / ws %zu\n", n_in, ws_size); grid = -1; return; }
        int dev = 0, cus = 0, per_cu = 0;
        hipGetDevice(&dev); hipDeviceGetAttribute(&cus, hipDeviceAttributeMultiprocessorCount, dev);
        if (hipFuncSetAttribute((const void*)fwd_kernel, hipFuncAttributeMaxDynamicSharedMemorySize, LDS_BYTES) != hipSuccess) { fprintf(stderr, "kernel_launch: hipFuncSetAttribute failed\n"); grid = -1; return; }
        hipOccupancyMaxActiveBlocksPerMultiprocessor(&per_cu, (const void*)fwd_kernel, 512, LDS_BYTES);
        if (per_cu < 1) { fprintf(stderr, "kernel_launch: occupancy query says %d\n", per_cu); per_cu = 1; }
        (void)hipGetLastError();
        grid = cus * 1;
    }
    if (grid < 0) return;
    hipMemsetAsync((char*)d_ws + WS_CTL, 0, 32768, stream);
    Params p{};
    for (int i = 0; i < 30; ++i) p.in[i] = (const float*)d_in[i];
    p.out = (float*)d_out; p.ws = (unsigned char*)d_ws;
    int lo = 0, hi = PH_HI;
    void* args[] = {&p, &lo, &hi};
    hipError_t e = hipLaunchCooperativeKernel((const void*)fwd_kernel, dim3(grid), dim3(512), args, LDS_BYTES, stream);
    if (e != hipSuccess) fprintf(stderr, "cooperative launch failed: %s (grid %d)\n", hipGetErrorString(e), grid);
}
```
